# Optimizing an MI355X kernel written in HIP

```python
import math
import jax, jax.numpy as jnp
from jax import lax
import numpy as np

D_MODEL = 1024
BATCH = 16
SEQ = 4096
DEPTH = 1

LRU_WIDTH = D_MODEL
LRU_HEADS = 16
LRU_HEAD_DIM = LRU_WIDTH // LRU_HEADS
LRU_C = 8.0
CONV_WIDTH = 4
SSD_INNER = 2 * D_MODEL
SSD_HEAD_DIM = 64
SSD_HEADS = SSD_INNER // SSD_HEAD_DIM
SSD_GROUPS = 8
SSD_HPG = SSD_HEADS // SSD_GROUPS
SSD_STATE = 128
SSD_CHUNK = 128
SSD_CONV_DIM = SSD_INNER + 2 * SSD_GROUPS * SSD_STATE
N_BRANCH = 2
D_FF = 4 * D_MODEL
N_MOD = 6
EPS = 1e-6
IN_SIZES = (LRU_WIDTH, LRU_WIDTH, SSD_INNER, SSD_CONV_DIM, SSD_HEADS, N_BRANCH * D_MODEL)
IN_DIM = sum(IN_SIZES)

kernel_name = "hybrid_rglru_ssd_gated_merge_block"


def rmsnorm(x, w):
    xf = x.astype(jnp.float32)
    y = xf * lax.rsqrt(jnp.mean(xf * xf, axis=-1, keepdims=True) + EPS)
    return (y * w.astype(jnp.float32)).astype(x.dtype)


def grouped_rmsnorm(y, w):
    b, s, d = y.shape
    yf = y.astype(jnp.float32).reshape(b, s, SSD_GROUPS, d // SSD_GROUPS)
    yf = yf * lax.rsqrt(jnp.mean(yf * yf, axis=-1, keepdims=True) + EPS)
    return (yf.reshape(b, s, d) * w.astype(jnp.float32)).astype(y.dtype)


def causal_dwconv(x, w, b):
    s = x.shape[1]
    xp = jnp.pad(x, ((0, 0), (CONV_WIDTH - 1, 0), (0, 0)))
    return sum((xp[:, k:k + s] * w[k] for k in range(CONV_WIDTH)), b)


def rglru(x, w_a, b_a, w_x, b_x, lam):
    bsz, s, _ = x.shape
    xh = x.reshape(bsz, s, LRU_HEADS, LRU_HEAD_DIM)
    r = jax.nn.sigmoid(jnp.einsum('bshi,hij->bshj', xh, w_a).reshape(bsz, s, LRU_WIDTH) + b_a)
    i = jax.nn.sigmoid(jnp.einsum('bshi,hij->bshj', xh, w_x).reshape(bsz, s, LRU_WIDTH) + b_x)
    log_a = (-LRU_C * r.astype(jnp.float32)) * jax.nn.softplus(-lam.astype(jnp.float32))
    a = jnp.exp(log_a)
    u = jnp.sqrt(-jnp.expm1(2.0 * log_a)) * (i * x).astype(jnp.float32)

    def combine(left, right):
        a1, b1 = left
        a2, b2 = right
        return a1 * a2, a2 * b1 + b2

    _, h = lax.associative_scan(combine, (a, u), axis=1)
    return h.astype(x.dtype)


def ssd_chunked_scan(xs, dt, A, Bm, Cm):
    bsz, s = xs.shape[:2]
    nc, L = s // SSD_CHUNK, SSD_CHUNK

    def to_chunks(t):
        return jnp.moveaxis(t.reshape((bsz, nc, L) + t.shape[2:]), 1, 0)

    xdt = (xs * dt[..., None]).reshape(bsz, s, SSD_GROUPS, SSD_HPG, SSD_HEAD_DIM)
    dA = (dt * A).reshape(bsz, s, SSD_GROUPS, SSD_HPG)
    causal = jnp.tril(jnp.ones((L, L), dtype=bool))[None, :, :, None, None]

    def step(state, inp):
        x_c, dA_c, B_c, C_c = inp
        cs = jnp.cumsum(dA_c, axis=1)
        seg = cs[:, :, None] - cs[:, None, :]
        decay = jnp.exp(jnp.where(causal, seg, -jnp.inf))
        cb = jnp.einsum('blgn,bsgn->blsg', C_c, B_c)
        y_diag = jnp.einsum('blsge,bsgep->blgep', cb[..., None] * decay, x_c)
        y_off = jnp.einsum('blgn,bgepn->blgep', C_c, state) * jnp.exp(cs)[..., None]
        decay_to_end = jnp.exp(cs[:, -1:] - cs)
        new_state = state * jnp.exp(cs[:, -1])[..., None, None] + jnp.einsum(
            'blgn,blgep->bgepn', B_c, x_c * decay_to_end[..., None])
        return new_state, y_diag + y_off

    init = jnp.zeros((bsz, SSD_GROUPS, SSD_HPG, SSD_HEAD_DIM, SSD_STATE), jnp.float32)
    _, y = lax.scan(step, init, (to_chunks(xdt), to_chunks(dA), to_chunks(Bm), to_chunks(Cm)))
    return jnp.moveaxis(y, 0, 1).reshape(bsz, s, SSD_HEADS, SSD_HEAD_DIM)


def ssd_branch(z, xbc, dt_raw, conv_w, conv_b, dt_bias, a_log, d_skip, norm_w):
    bsz, s, _ = z.shape
    xbc = jax.nn.silu(causal_dwconv(xbc, conv_w, conv_b))
    xs, Bm, Cm = jnp.split(xbc, [SSD_INNER, SSD_INNER + SSD_GROUPS * SSD_STATE], axis=-1)
    xs = xs.astype(jnp.float32).reshape(bsz, s, SSD_HEADS, SSD_HEAD_DIM)
    Bm = Bm.astype(jnp.float32).reshape(bsz, s, SSD_GROUPS, SSD_STATE)
    Cm = Cm.astype(jnp.float32).reshape(bsz, s, SSD_GROUPS, SSD_STATE)
    dt = jax.nn.softplus(dt_raw.astype(jnp.float32) + dt_bias.astype(jnp.float32))
    A = -jnp.exp(a_log.astype(jnp.float32))
    y = ssd_chunked_scan(xs, dt, A, Bm, Cm)
    y = y + d_skip.astype(jnp.float32)[:, None] * xs
    y = y.reshape(bsz, s, SSD_INNER) * jax.nn.silu(z.astype(jnp.float32))
    return grouped_rmsnorm(y, norm_w).astype(z.dtype)


def temporal_mixer(h, w_in, b_gate, lru_conv_w, lru_conv_b, lru_wa, lru_ba, lru_wx, lru_bx,
                   lru_lambda, w_pa, ssd_conv_w, ssd_conv_b, ssd_dt_bias, ssd_a_log, ssd_d,
                   ssd_norm_w, w_pb, w_out):
    bsz, s, _ = h.shape
    proj = h @ w_in
    lru_x, lru_g, ssd_z, ssd_xbc, ssd_dt, gates = jnp.split(
        proj, [int(v) for v in np.cumsum(IN_SIZES)[:-1]], axis=-1)
    ra = rglru(causal_dwconv(lru_x, lru_conv_w, lru_conv_b), lru_wa, lru_ba, lru_wx, lru_bx, lru_lambda)
    y_a = (ra * jax.nn.gelu(lru_g)) @ w_pa
    y_b = ssd_branch(ssd_z, ssd_xbc, ssd_dt, ssd_conv_w, ssd_conv_b, ssd_dt_bias, ssd_a_log,
                     ssd_d, ssd_norm_w) @ w_pb
    g = jax.nn.sigmoid(gates + b_gate).reshape(bsz, s, N_BRANCH, D_MODEL)
    merged = g[:, :, 0] * y_a + g[:, :, 1] * y_b
    return merged @ w_out


def setup_inputs(seed: int = 0) -> dict:
    key = jax.random.key(seed)
    ks = jax.random.split(key, 32)
    f32 = jnp.float32

    def nrm(k, shape, scale):
        return jax.random.normal(k, shape, f32) * scale

    def gain(k, shape):
        return 1.0 + 0.1 * jax.random.normal(k, shape, f32)

    L = DEPTH
    u = jax.random.uniform(ks[12], (L, LRU_WIDTH), f32, minval=0.9, maxval=0.999)
    sroot = u ** (1.0 / LRU_C)
    lru_lambda = jnp.log(sroot) - jnp.log1p(-sroot)
    dt0 = jnp.exp(jax.random.uniform(ks[16], (L, SSD_HEADS), f32,
                                     minval=math.log(1e-3), maxval=math.log(1e-1)))
    ssd_dt_bias = dt0 + jnp.log(-jnp.expm1(-dt0))
    ssd_a_log = jnp.log(jax.random.uniform(ks[17], (L, SSD_HEADS), f32, minval=1.0, maxval=16.0))
    return {
        "x": jax.random.normal(ks[0], (BATCH, SEQ, D_MODEL), f32),
        "c": jax.random.normal(ks[1], (BATCH, D_MODEL), f32),
        "w_ada": nrm(ks[2], (L, D_MODEL, N_MOD * D_MODEL), 0.5 * D_MODEL ** -0.5),
        "b_ada": nrm(ks[3], (L, N_MOD * D_MODEL), 0.01),
        "pre_norm1": gain(ks[4], (L, D_MODEL)),
        "post_norm1": gain(ks[5], (L, D_MODEL)),
        "w_in": nrm(ks[6], (L, D_MODEL, IN_DIM), D_MODEL ** -0.5),
        "b_gate": nrm(ks[7], (L, N_BRANCH * D_MODEL), 0.01),
        "lru_conv_w": nrm(ks[8], (L, CONV_WIDTH, LRU_WIDTH), CONV_WIDTH ** -0.5),
        "lru_conv_b": nrm(ks[9], (L, LRU_WIDTH), 0.01),
        "lru_wa": nrm(ks[10], (L, LRU_HEADS, LRU_HEAD_DIM, LRU_HEAD_DIM), LRU_HEAD_DIM ** -0.5),
        "lru_ba": nrm(ks[11], (L, LRU_WIDTH), 0.01),
        "lru_wx": nrm(ks[13], (L, LRU_HEADS, LRU_HEAD_DIM, LRU_HEAD_DIM), LRU_HEAD_DIM ** -0.5),
        "lru_bx": nrm(ks[14], (L, LRU_WIDTH), 0.01),
        "lru_lambda": lru_lambda,
        "w_pa": nrm(ks[15], (L, LRU_WIDTH, D_MODEL), LRU_WIDTH ** -0.5),
        "ssd_conv_w": nrm(ks[18], (L, CONV_WIDTH, SSD_CONV_DIM), CONV_WIDTH ** -0.5),
        "ssd_conv_b": nrm(ks[19], (L, SSD_CONV_DIM), 0.01),
        "ssd_dt_bias": ssd_dt_bias,
        "ssd_a_log": ssd_a_log,
        "ssd_d": gain(ks[20], (L, SSD_HEADS)),
        "ssd_norm_w": gain(ks[21], (L, SSD_INNER)),
        "w_pb": nrm(ks[22], (L, SSD_INNER, D_MODEL), SSD_INNER ** -0.5),
        "w_out": nrm(ks[23], (L, D_MODEL, D_MODEL), D_MODEL ** -0.5),
        "pre_norm2": gain(ks[24], (L, D_MODEL)),
        "post_norm2": gain(ks[25], (L, D_MODEL)),
        "w_ff1": nrm(ks[26], (L, D_MODEL, D_FF), D_MODEL ** -0.5),
        "w_ff2": nrm(ks[27], (L, D_FF, D_MODEL), D_FF ** -0.5),
    }


def reference(x, c, w_ada, b_ada, pre_norm1, post_norm1, w_in, b_gate, lru_conv_w, lru_conv_b,
              lru_wa, lru_ba, lru_wx, lru_bx, lru_lambda, w_pa, ssd_conv_w, ssd_conv_b,
              ssd_dt_bias, ssd_a_log, ssd_d, ssd_norm_w, w_pb, w_out, pre_norm2, post_norm2,
              w_ff1, w_ff2):
    c_act = jax.nn.silu(c)
    for l in range(DEPTH):
        mod = (c_act @ w_ada[l] + b_ada[l])[:, None, :]
        sh1, sc1, g1, sh2, sc2, g2 = jnp.split(mod, N_MOD, axis=-1)
        h = rmsnorm(x, pre_norm1[l]) * (1.0 + sc1) + sh1
        y = temporal_mixer(h, w_in[l], b_gate[l], lru_conv_w[l], lru_conv_b[l], lru_wa[l],
                           lru_ba[l], lru_wx[l], lru_bx[l], lru_lambda[l], w_pa[l],
                           ssd_conv_w[l], ssd_conv_b[l], ssd_dt_bias[l], ssd_a_log[l], ssd_d[l],
                           ssd_norm_w[l], w_pb[l], w_out[l])
        x = x + g1 * rmsnorm(y, post_norm1[l])
        h = rmsnorm(x, pre_norm2[l]) * (1.0 + sc2) + sh2
        y = jnp.square(jax.nn.relu(h @ w_ff1[l])) @ w_ff2[l]
        x = x + g2 * rmsnorm(y, post_norm2[l])
    return x
```

```cpp
#include <hip/hip_runtime.h>
#include <hip/hip_cooperative_groups.h>
#include <cstdio>
namespace cg = cooperative_groups;

#define LAS __attribute__((address_space(3)))
typedef unsigned short bf16_t;
typedef short bf16x8 __attribute__((ext_vector_type(8)));
typedef float f32x4 __attribute__((ext_vector_type(4)));
typedef unsigned u32x4 __attribute__((ext_vector_type(4)));
typedef unsigned u32x2 __attribute__((ext_vector_type(2)));

constexpr int DM = 1024, BATCH = 16, SEQ = 4096, NB = 2, BG = BATCH / NB, TG = BG * SEQ;
constexpr int NIN = 10240;
constexpr int NMOD = 6 * DM;
constexpr float EPS = 1e-6f;
constexpr int NTHREADS = 512;
constexpr int LDS_BYTES = 131072 + 256;

constexpr size_t MiB = 1024ull * 1024ull;
constexpr size_t WS_WIN = 0;
constexpr size_t WS_WDT = WS_WIN + (size_t)NIN * 1024 * 2;
constexpr size_t WS_WPA = WS_WDT + 32 * 1024 * 2;
constexpr size_t WS_WPB = WS_WPA + 2 * MiB;
constexpr size_t WS_WOUT = WS_WPB + 4 * MiB;
constexpr size_t WS_WFF1 = WS_WOUT + 2 * MiB;
constexpr size_t WS_WFF2 = WS_WFF1 + 8 * MiB;
constexpr size_t WS_WAT = WS_WFF2 + 8 * MiB;
constexpr size_t WS_WXT = WS_WAT + 131072;
constexpr size_t WS_MODP = WS_WXT + 131072;
constexpr size_t WS_MOD = WS_MODP + 16ull * 16 * NMOD * 4;
constexpr size_t WS_CAR = WS_MOD + 16ull * NMOD * 4;
constexpr size_t WS_DT = WS_CAR + (size_t)BG * 64 * 1024 * 8;
constexpr size_t WS_H = WS_DT + (size_t)TG * 32 * 4;
constexpr size_t WS_LX = WS_H + (size_t)TG * 1024 * 2;
constexpr size_t WS_LG = WS_LX + (size_t)TG * 1024 * 2;
constexpr size_t WS_Z = WS_LG + (size_t)TG * 1024 * 2;
constexpr size_t WS_XBC = WS_Z + (size_t)TG * 2048 * 2;
constexpr size_t WS_GT = WS_XBC + (size_t)TG * 4096 * 2;
constexpr size_t WS_YB = WS_GT + (size_t)TG * 2048 * 2;
constexpr size_t WS_CS = WS_YB + (size_t)TG * 2048 * 2;
constexpr size_t WS_BAR = WS_CS + (size_t)TG * 32 * 4;
constexpr size_t WS_END = WS_BAR + 16384;

struct Args { const float* in[28]; float* out; unsigned char* ws; };
typedef const __attribute__((address_space(4))) Args CArgs;

__device__ __forceinline__ bf16_t f2bf(float f) { unsigned u = __float_as_uint(f); u += 0x7FFFu + ((u >> 16) & 1u); return (bf16_t)(u >> 16); }
__device__ __forceinline__ float bf2f(bf16_t b) { return __uint_as_float(((unsigned)b) << 16); }
typedef __bf16 bf16x2_t __attribute__((ext_vector_type(2)));
typedef float f32x2_t __attribute__((ext_vector_type(2)));
__device__ __forceinline__ unsigned pack2(float lo, float hi) { const f32x2_t v = {lo, hi}; return __builtin_bit_cast(unsigned, __builtin_convertvector(v, bf16x2_t)); }
__device__ __forceinline__ float bflo(unsigned w) { return __uint_as_float(w << 16); }
__device__ __forceinline__ float bfhi(unsigned w) { return __uint_as_float(w & 0xffff0000u); }
__device__ __forceinline__ float sigmoidf_(float x) { return __builtin_amdgcn_rcpf(1.0f + __expf(-x)); }
__device__ __forceinline__ float siluf_(float x) { return x * sigmoidf_(x); }
__device__ __forceinline__ float geluf_(float x) { return x * sigmoidf_(1.5957691216f * (x + 0.044715f * x * x * x)); }
__device__ __forceinline__ float softplusf_(float x) { return x > 20.f ? x : log1pf(expf(x)); }
__device__ __forceinline__ float wave_sum(float s, int lane) {
#pragma unroll
    for (int o = 32; o > 0; o >>= 1) s += __int_as_float(__builtin_amdgcn_ds_bpermute((lane ^ o) << 2, __float_as_int(s)));
    return s;
}

__device__ __forceinline__ int otid() { int t = threadIdx.x; asm volatile("" : "+v"(t)); return t; }
__device__ __forceinline__ CArgs* launder(CArgs* p) { asm volatile("" : "+s"(p)); return p; }
__device__ __forceinline__ int obid() { int t = blockIdx.x; asm volatile("" : "+s"(t)); return t; }

#define XB_TMO      128
#define XB_XCNT(j)  (256  + 64 * (j))
#define XB_XSUB(j)  (1280 + 64 * (j))
#define XB_XGEN(j)  (2304 + 64 * (j))
#define XB_TOP      3328
#define XB_TOPGEN   3392
#define XCD_BAR_WORDS 3456
#define XB_SPIN_CAP (1u << 18)
__device__ __forceinline__ unsigned xb_ld(unsigned* p)              { return __hip_atomic_load(p, __ATOMIC_RELAXED, __HIP_MEMORY_SCOPE_AGENT); }
__device__ __forceinline__ unsigned xb_add(unsigned* p, unsigned v) { return __hip_atomic_fetch_add(p, v, __ATOMIC_RELAXED, __HIP_MEMORY_SCOPE_AGENT); }
__device__ __forceinline__ unsigned xb_xcc_id() { return (unsigned)__builtin_amdgcn_s_getreg((3 << 11) | 20) & 0xFu; }
#define XB_SPIN(cond, bar) do { unsigned _sp = 0; while (cond) { __builtin_amdgcn_s_sleep(1); \
    if ((++_sp & 255u) == 0u) { if (xb_ld(&(bar)[XB_TMO])) break; if (_sp > XB_SPIN_CAP) { atomicAdd(&(bar)[XB_TMO], 1u); break; } } } } while (0)
struct XcdBarrier { unsigned* bar; unsigned x; volatile LAS unsigned* st; };
__device__ __forceinline__ XcdBarrier xcd_barrier_post(unsigned* bar, volatile LAS unsigned* st) {
    XcdBarrier b; b.bar = bar; b.x = xb_xcc_id(); b.st = st;
    if (threadIdx.x == 0) (void)xb_add(&bar[XB_XCNT(b.x)], 1u);
    return b;
}
__device__ __forceinline__ void xcd_barrier_complete(unsigned* bar, unsigned x, unsigned& nloc, unsigned& nx) {
    const unsigned G = gridDim.x * gridDim.y * gridDim.z;
    unsigned sum, cnt, mine, sp = 0u;
    for (;;) {
        sum = 0u; cnt = 0u; mine = 0u;
#pragma unroll
        for (unsigned j = 0; j < 16; ++j) { const unsigned c = xb_ld(&bar[XB_XCNT(j)]); sum += c; cnt += (c > 0u) ? 1u : 0u; mine = (j == x) ? c : mine; }
        if (sum == G) break;
        __builtin_amdgcn_s_sleep(1);
        if ((++sp & 255u) == 0u) { if (xb_ld(&bar[XB_TMO])) break; if (sp > XB_SPIN_CAP) { atomicAdd(&bar[XB_TMO], 1u); break; } }
    }
    nloc = mine > 0u ? mine : 1u; nx = cnt > 0u ? cnt : 1u;
}
__device__ __forceinline__ void xcd_barrier(const XcdBarrier& b) {
    asm volatile("s_waitcnt vmcnt(0)" ::: "memory");
    __syncthreads();
    if (threadIdx.x == 0) {
        unsigned* bar = b.bar;
        __builtin_amdgcn_s_waitcnt(0);
        unsigned nloc = b.st[0], nx = b.st[1];
        if (nloc == 0u) { xcd_barrier_complete(bar, b.x, nloc, nx); b.st[0] = nloc; b.st[1] = nx; }
        const unsigned old = xb_add(&bar[XB_XSUB(b.x)], 1u);
        const unsigned gen = old / nloc;
        if (old + 1u == (gen + 1u) * nloc) {
            __builtin_amdgcn_fence(__ATOMIC_RELEASE, "agent");
            asm volatile("s_waitcnt vmcnt(0)" ::: "memory");
            const unsigned og = xb_add(&bar[XB_TOP], 1u);
            const unsigned tg = og / nx;
            if (og + 1u == (tg + 1u) * nx) xb_add(&bar[XB_TOPGEN], 1u);
            else XB_SPIN(xb_ld(&bar[XB_TOPGEN]) == tg, bar);
            __builtin_amdgcn_fence(__ATOMIC_ACQUIRE, "agent");
            xb_add(&bar[XB_XGEN(b.x)], 1u);
            asm volatile("s_waitcnt vmcnt(0)" ::: "memory");
        } else {
            XB_SPIN(xb_ld(&bar[XB_XGEN(b.x)]) == gen, bar);
            __builtin_amdgcn_fence(__ATOMIC_ACQUIRE, "agent");
            asm volatile("s_waitcnt vmcnt(0)" ::: "memory");
        }
    }
    __syncthreads();
}

namespace pg8 {
constexpr int BM = 256, BK = 64, HALF = 128, HTB = HALF * BK * 2, STAGE_BYTES = 8 * HTB, NXCD = 8, WGM = 8;
__device__ __forceinline__ int lds_byte(int r, int c) { const int st = (r >> 4) * 2 + (c >> 5), rr = r & 15, cc = c & 31, ob = rr * 64 + cc * 2; return st * 1024 + (ob ^ (((ob >> 9) & 1) << 5)); }
__device__ __forceinline__ void stage_rc(int b, int& R, int& C) { const int st = b / 1024, sb = b % 1024, swz = sb ^ (((sb >> 9) & 1) << 5); R = (st >> 1) * 16 + swz / 64; C = (st & 1) * 32 + (swz % 64) / 2; }
__device__ __forceinline__ int perm32(int rho) { const int n = rho >> 4, i = rho & 15; return 8 * (i >> 2) + 4 * n + (i & 3); }
struct Unit { int pm, pn; };
struct Gemm { const bf16_t* A; const bf16_t* Bt; int M, N, K; };
struct StaticOrder {
    int nM, nN, nwg, G, c, mode;
    __device__ void init(int M, int N, int G_, int c_, int mode_ = 0) { nM = M / BM; nN = N / BM; nwg = nM * nN; G = G_; c = c_; mode = mode_; }
    __device__ bool next(int i, Unit& u) const {
        const long L = (long)i * G + c; if (L >= nwg) return false;
        if (mode == 1 && (G & 7) == 0 && (nN & 7) == 0 && nwg % G == 0) {
            const int x = c & 7, slot = (c >> 3) + (G >> 3) * i, npx = nN >> 3;
            u.pm = slot / npx; u.pn = x * npx + slot % npx; return true; }
        int wgid = (int)L; { const int q = nwg / NXCD, r = nwg % NXCD, xcd = wgid % NXCD, off = wgid / NXCD; wgid = (xcd < r ? xcd * (q + 1) : r * (q + 1) + (xcd - r) * q) + off; }
        const int nig = WGM * nN, gid = wgid / nig, fm = gid * WGM, gsz = (nM - fm) < WGM ? (nM - fm) : WGM;
        u.pm = fm + ((wgid % nig) % gsz); u.pn = (wgid % nig) / gsz; return true;
    }
};

template <class Epi>
__device__ __forceinline__ void gemm_phase(LAS unsigned char* lds, const Gemm g, const StaticOrder& S, const Epi& E) {
    const int tid = otid(), wid = __builtin_amdgcn_readfirstlane(tid >> 6), lane = tid & 63, wr = wid >> 2, wc = wid & 3, fr = lane & 15, fq = lane >> 4;
    const int K = g.K, nt = K / BK;
    unsigned voffA[2], voffB[2];
#pragma unroll
    for (int i = 0; i < 2; ++i) { int R, C; stage_rc(tid * 16 + i * 8192, R, C); const int Rb = ((R & ~31) + perm32(R & 31));
        voffA[i] = (unsigned)(R * K + C) * 2u; voffB[i] = (unsigned)(Rb * K + C) * 2u; }
    const size_t kstep = (size_t)(BK * 2);
    const size_t hstep = (size_t)HALF * K * 2;
    const size_t tstep = 2 * hstep;
    const unsigned ldsw = (unsigned)wid * 1024u;
    const int aoff = lds_byte(wr * 64 + fr, fq * 8), boff = lds_byte(wc * 32 + fr, fq * 8);
#define PG8_SA(b, h) (((b) * 2 + (h)) * HTB)
#define PG8_SB(b, h) ((4 + (b) * 2 + (h)) * HTB)
#define PG8_STAGE(bufoff, gbase, voff) do { _Pragma("unroll") for (int _i = 0; _i < 2; ++_i) \
        __builtin_amdgcn_global_load_lds((const unsigned*)((const char*)(gbase) + (voff)[_i]), (LAS unsigned*)(lds + (bufoff) + ldsw + _i * 8192), 16, 0, 0); } while (0)
#define PG8_LDA(dst, b, h) do { _Pragma("unroll") for (int m = 0; m < 4; ++m) _Pragma("unroll") for (int k = 0; k < 2; ++k) dst[m][k] = *(const LAS bf16x8*)(lds + PG8_SA(b, h) + aoff + m * 2048 + k * 1024); } while (0)
#define PG8_LDB(dst, b, h) do { _Pragma("unroll") for (int n = 0; n < 2; ++n) _Pragma("unroll") for (int k = 0; k < 2; ++k) dst[n][k] = *(const LAS bf16x8*)(lds + PG8_SB(b, h) + boff + n * 2048 + k * 1024); } while (0)
#define PG8_MMA(ai, bj, At, Bt) do { __builtin_amdgcn_s_setprio(1); _Pragma("unroll") for (int m = 0; m < 4; ++m) _Pragma("unroll") for (int n = 0; n < 2; ++n) _Pragma("unroll") for (int k = 0; k < 2; ++k) \
        acc[ai][bj][m][n] = __builtin_amdgcn_mfma_f32_16x16x32_bf16(Bt[n][k], At[m][k], acc[ai][bj][m][n], 0, 0, 0); __builtin_amdgcn_s_setprio(0); } while (0)
#define PG8_WAIT_V(n) asm volatile("s_waitcnt vmcnt(" #n ")" ::: "memory")
#define PG8_WAIT_L(n) asm volatile("s_waitcnt lgkmcnt(" #n ")" ::: "memory")
#define PG8_BAR __builtin_amdgcn_s_barrier()
#define PG8_SCHED __builtin_amdgcn_sched_barrier(0)
    Unit cur, nxt; int ui = 0;
    if (!S.next(0, cur)) return;
    f32x4 acc[2][2][4][2];
#pragma unroll
    for (int a = 0; a < 2; ++a)
#pragma unroll
        for (int b = 0; b < 2; ++b)
#pragma unroll
            for (int m = 0; m < 4; ++m)
#pragma unroll
                for (int n = 0; n < 2; ++n) acc[a][b][m][n] = (f32x4){0.f, 0.f, 0.f, 0.f};
    bf16x8 At[4][2], B0[2][2], B1[2][2];
    const char* cA = (const char*)g.A + (size_t)cur.pm * tstep; const char* cB = (const char*)g.Bt + (size_t)cur.pn * tstep;
    PG8_STAGE(PG8_SB(0, 0), cB, voffB); PG8_STAGE(PG8_SA(0, 0), cA, voffA); PG8_STAGE(PG8_SB(0, 1), cB + hstep, voffB); PG8_STAGE(PG8_SA(0, 1), cA + hstep, voffA);
    if (wr == 1) PG8_BAR;
    PG8_WAIT_V(4); PG8_BAR;
    PG8_STAGE(PG8_SB(1, 0), cB + kstep, voffB); PG8_STAGE(PG8_SA(1, 0), cA + kstep, voffA); PG8_STAGE(PG8_SB(1, 1), cB + hstep + kstep, voffB);
    PG8_WAIT_V(6); PG8_BAR;
    for (;;) {
        const bool has_next = S.next(ui + 1, nxt);
        const char* nA = has_next ? (const char*)g.A + (size_t)nxt.pm * tstep : cA; const char* nB = has_next ? (const char*)g.Bt + (size_t)nxt.pn * tstep : cB;
        for (int t = 0; t < nt; t += 2) {
            const bool last = (t == nt - 2);
            const char* a1 = cA + (size_t)(t + 1) * kstep;
            const char* a2 = last ? nA : cA + (size_t)(t + 2) * kstep; const char* b2 = last ? nB : cB + (size_t)(t + 2) * kstep;
            const char* a3 = a2 + kstep; const char* b3 = b2 + kstep;
            PG8_LDB(B0, 0, 0); PG8_SCHED; PG8_LDA(At, 0, 0); PG8_STAGE(PG8_SA(1, 1), a1 + hstep, voffA);
            PG8_WAIT_L(8); PG8_BAR; PG8_WAIT_L(0); PG8_MMA(0, 0, At, B0); PG8_BAR; PG8_SCHED;
            PG8_LDB(B1, 0, 1); PG8_STAGE(PG8_SB(0, 0), b2, voffB);
            PG8_BAR; PG8_WAIT_L(0); PG8_MMA(0, 1, At, B1); PG8_BAR;
            PG8_LDA(At, 0, 1); PG8_STAGE(PG8_SA(0, 0), a2, voffA);
            PG8_BAR; PG8_WAIT_L(0); PG8_MMA(1, 0, At, B0); PG8_BAR; PG8_SCHED;
            PG8_STAGE(PG8_SB(0, 1), b2 + hstep, voffB);
            PG8_WAIT_V(6); PG8_BAR; PG8_MMA(1, 1, At, B1); PG8_BAR;
            PG8_LDB(B0, 1, 0); PG8_SCHED; PG8_LDA(At, 1, 0); PG8_STAGE(PG8_SA(0, 1), a2 + hstep, voffA);
            PG8_WAIT_L(8); PG8_BAR; PG8_WAIT_L(0); PG8_MMA(0, 0, At, B0); PG8_BAR; PG8_SCHED;
            PG8_LDB(B1, 1, 1); PG8_STAGE(PG8_SB(1, 0), b3, voffB);
            PG8_BAR; PG8_WAIT_L(0); PG8_MMA(0, 1, At, B1); PG8_BAR;
            PG8_LDA(At, 1, 1); PG8_STAGE(PG8_SA(1, 0), a3, voffA);
            PG8_BAR; PG8_WAIT_L(0); PG8_MMA(1, 0, At, B0); PG8_BAR; PG8_SCHED;
            PG8_STAGE(PG8_SB(1, 1), b3 + hstep, voffB);
            PG8_WAIT_V(6); PG8_BAR; PG8_MMA(1, 1, At, B1); PG8_BAR;
        }
        E(acc, cur, wr, wc, fr, fq);
        if (!has_next) break;
#pragma unroll
        for (int a = 0; a < 2; ++a)
#pragma unroll
            for (int b = 0; b < 2; ++b)
#pragma unroll
                for (int m = 0; m < 4; ++m)
#pragma unroll
                    for (int n = 0; n < 2; ++n) acc[a][b][m][n] = (f32x4){0.f, 0.f, 0.f, 0.f};
        cur = nxt; cA = nA; cB = nB; ++ui;
    }
    PG8_WAIT_V(0);
    if (wr == 0) PG8_BAR;
    PG8_BAR;
#undef PG8_SA
#undef PG8_SB
#undef PG8_STAGE
#undef PG8_LDA
#undef PG8_LDB
#undef PG8_MMA
#undef PG8_WAIT_V
#undef PG8_WAIT_L
#undef PG8_BAR
#undef PG8_SCHED
}
}

#define EPI_LOOP_BEGIN \
    const int row0 = u.pm * 256 + wr * 64 + fr, col0 = u.pn * 256 + wc * 32 + 8 * fq; \
    _Pragma("unroll") for (int ai = 0; ai < 2; ++ai) _Pragma("unroll") for (int m = 0; m < 4; ++m) { const int row = row0 + ai * 128 + m * 16; \
    _Pragma("unroll") for (int bj = 0; bj < 2; ++bj) { const int col = col0 + bj * 128; f32x4 v0 = acc[ai][bj][m][0], v1 = acc[ai][bj][m][1];
#define EPI_LOOP_END } }

__device__ __forceinline__ u32x4 pack8(f32x4 v0, f32x4 v1) { u32x4 w; w.x = pack2(v0[0], v0[1]); w.y = pack2(v0[2], v0[3]); w.z = pack2(v1[0], v1[1]); w.w = pack2(v1[2], v1[3]); return w; }

struct EpiIn {
    bf16_t *LX, *LG, *Z, *XBC, *GT;
    __device__ __forceinline__ void operator()(const f32x4 (&acc)[2][2][4][2], const pg8::Unit& u, int wr, int wc, int fr, int fq) const {
        const int pn = u.pn; bf16_t* O; int ld, cb;
        if (pn < 4) { O = LX; ld = 1024; cb = 0; } else if (pn < 8) { O = LG; ld = 1024; cb = 1024; } else if (pn < 16) { O = Z; ld = 2048; cb = 2048; }
        else if (pn < 32) { O = XBC; ld = 4096; cb = 4096; } else { O = GT; ld = 2048; cb = 8192; }
        const bool zact = (pn >= 8 && pn < 16);
        EPI_LOOP_BEGIN
            if (zact) {
#pragma unroll
                for (int j = 0; j < 4; ++j) { v0[j] = siluf_(v0[j]); v1[j] = siluf_(v1[j]); } }
            *(u32x4*)(O + (size_t)row * ld + (col - cb)) = pack8(v0, v1);
        EPI_LOOP_END
    }
};
struct EpiPa {
    bf16_t* TMP; const bf16_t* GT; const float* b_gate;
    __device__ __forceinline__ void operator()(const f32x4 (&acc)[2][2][4][2], const pg8::Unit& u, int wr, int wc, int fr, int fq) const {
        const int row0 = u.pm * 256 + wr * 64 + fr, col0 = u.pn * 256 + wc * 32 + 8 * fq;
        f32x4 bia[2][2];
#pragma unroll
        for (int bj = 0; bj < 2; ++bj) { bia[bj][0] = *(const f32x4*)(b_gate + col0 + bj * 128); bia[bj][1] = *(const f32x4*)(b_gate + col0 + bj * 128 + 4); }
#pragma unroll
        for (int aih = 0; aih < 4; ++aih) { const int ai = aih >> 1, mb = (aih & 1) * 2;
            u32x4 gw[4][2];
#pragma unroll
            for (int m = mb; m < mb + 2; ++m)
#pragma unroll
                for (int bj = 0; bj < 2; ++bj) gw[m][bj] = *(const u32x4*)(GT + (size_t)(row0 + ai * 128 + m * 16) * 2048 + col0 + bj * 128);
#pragma unroll
            for (int m = mb; m < mb + 2; ++m)
#pragma unroll
                for (int bj = 0; bj < 2; ++bj) {
                    f32x4 v0 = acc[ai][bj][m][0], v1 = acc[ai][bj][m][1]; const u32x4 g = gw[m][bj]; const f32x4 b0 = bia[bj][0], b1 = bia[bj][1];
                    v0[0] *= sigmoidf_(bflo(g.x) + b0[0]); v0[1] *= sigmoidf_(bfhi(g.x) + b0[1]); v0[2] *= sigmoidf_(bflo(g.y) + b0[2]); v0[3] *= sigmoidf_(bfhi(g.y) + b0[3]);
                    v1[0] *= sigmoidf_(bflo(g.z) + b1[0]); v1[1] *= sigmoidf_(bfhi(g.z) + b1[1]); v1[2] *= sigmoidf_(bflo(g.w) + b1[2]); v1[3] *= sigmoidf_(bfhi(g.w) + b1[3]);
                    *(u32x4*)(TMP + (size_t)(row0 + ai * 128 + m * 16) * 1024 + col0 + bj * 128) = pack8(v0, v1); }
        }
    }
};
struct EpiPb {
    const bf16_t* TMP; const bf16_t* GT; bf16_t* MG; const float* b_gate;
    __device__ __forceinline__ void operator()(const f32x4 (&acc)[2][2][4][2], const pg8::Unit& u, int wr, int wc, int fr, int fq) const {
        const int row0 = u.pm * 256 + wr * 64 + fr, col0 = u.pn * 256 + wc * 32 + 8 * fq;
        f32x4 bia[2][2];
#pragma unroll
        for (int bj = 0; bj < 2; ++bj) { bia[bj][0] = *(const f32x4*)(b_gate + 1024 + col0 + bj * 128); bia[bj][1] = *(const f32x4*)(b_gate + 1024 + col0 + bj * 128 + 4); }
#pragma unroll
        for (int aih = 0; aih < 4; ++aih) { const int ai = aih >> 1, mb = (aih & 1) * 2;
            u32x4 gw[4][2], tw[4][2];
#pragma unroll
            for (int m = mb; m < mb + 2; ++m)
#pragma unroll
                for (int bj = 0; bj < 2; ++bj) { const size_t r = (size_t)(row0 + ai * 128 + m * 16);
                    gw[m][bj] = *(const u32x4*)(GT + r * 2048 + 1024 + col0 + bj * 128); tw[m][bj] = *(const u32x4*)(TMP + r * 1024 + col0 + bj * 128); }
#pragma unroll
            for (int m = mb; m < mb + 2; ++m)
#pragma unroll
                for (int bj = 0; bj < 2; ++bj) {
                    f32x4 v0 = acc[ai][bj][m][0], v1 = acc[ai][bj][m][1]; const u32x4 g = gw[m][bj], t = tw[m][bj]; const f32x4 b0 = bia[bj][0], b1 = bia[bj][1];
                    v0[0] = bflo(t.x) + v0[0] * sigmoidf_(bflo(g.x) + b0[0]); v0[1] = bfhi(t.x) + v0[1] * sigmoidf_(bfhi(g.x) + b0[1]);
                    v0[2] = bflo(t.y) + v0[2] * sigmoidf_(bflo(g.y) + b0[2]); v0[3] = bfhi(t.y) + v0[3] * sigmoidf_(bfhi(g.y) + b0[3]);
                    v1[0] = bflo(t.z) + v1[0] * sigmoidf_(bflo(g.z) + b1[0]); v1[1] = bfhi(t.z) + v1[1] * sigmoidf_(bfhi(g.z) + b1[1]);
                    v1[2] = bflo(t.w) + v1[2] * sigmoidf_(bflo(g.w) + b1[2]); v1[3] = bfhi(t.w) + v1[3] * sigmoidf_(bfhi(g.w) + b1[3]);
                    *(u32x4*)(MG + (size_t)(row0 + ai * 128 + m * 16) * 1024 + col0 + bj * 128) = pack8(v0, v1); }
        }
    }
};
struct EpiBf {
    bf16_t* C; int ldc;
    __device__ __forceinline__ void operator()(const f32x4 (&acc)[2][2][4][2], const pg8::Unit& u, int wr, int wc, int fr, int fq) const {
        EPI_LOOP_BEGIN
            *(u32x4*)(C + (size_t)row * ldc + col) = pack8(v0, v1);
        EPI_LOOP_END
    }
};
struct EpiF32 {
    float* C; int ldc;
    __device__ __forceinline__ void operator()(const f32x4 (&acc)[2][2][4][2], const pg8::Unit& u, int wr, int wc, int fr, int fq) const {
        EPI_LOOP_BEGIN
            float* o = C + (size_t)row * ldc + col; *(f32x4*)o = v0; *(f32x4*)(o + 4) = v1;
        EPI_LOOP_END
    }
};
struct EpiRelu2 {
    bf16_t* O; int ldc;
    __device__ __forceinline__ void operator()(const f32x4 (&acc)[2][2][4][2], const pg8::Unit& u, int wr, int wc, int fr, int fq) const {
        EPI_LOOP_BEGIN
#pragma unroll
            for (int j = 0; j < 4; ++j) { const float a = fmaxf(v0[j], 0.f), b = fmaxf(v1[j], 0.f); v0[j] = a * a; v1[j] = b * b; }
            *(u32x4*)(O + (size_t)row * ldc + col) = pack8(v0, v1);
        EPI_LOOP_END
    }
};

__device__ void transpose_tile(const float* __restrict__ src, int K, int N, int tile, int job, bf16_t* dst, bf16_t* dst_dt, const float* kscale, float* T) {
    const int tid = otid();
    const int ntn = N / 32, tk = tile / ntn, tn = tile % ntn, k0 = tk * 64, n0 = tn * 32;
    __syncthreads();
#pragma unroll
    for (int i = 0; i < 4; ++i) { const int kk = (tid >> 5) + 16 * i, nn = tid & 31; float v = src[(size_t)(k0 + kk) * N + n0 + nn]; if (kscale) v *= kscale[k0 + kk]; T[kk * 33 + nn] = v; }
    __syncthreads();
    const int n = tid >> 4, kp = (tid & 15) * 4;
    int gn = n0 + n; bf16_t* base = dst;
    if (job == 0) { if (gn >= 8224) gn -= 32; else if (gn >= 8192) { gn -= 8192; base = dst_dt; } }
    u32x2 w; w.x = pack2(T[(kp + 0) * 33 + n], T[(kp + 1) * 33 + n]); w.y = pack2(T[(kp + 2) * 33 + n], T[(kp + 3) * 33 + n]);
    *(u32x2*)(base + (size_t)gn * K + k0 + kp) = w;
}

__device__ void phase_prep(CArgs& a, float* ldsf) {
    unsigned char* ws = a.ws; const int tid = otid(); const int bid = obid();
    const int nt0 = 16 * 321, nt1 = 16 * 32, nt2 = 32 * 32, nt3 = 16 * 32, nt4 = 16 * 128, nt5 = 64 * 32;
    const int tot = nt0 + nt1 + nt2 + nt3 + nt4 + nt5;
    for (int t = bid; t < tot; t += gridDim.x) {
        int r = t;
        if (r < nt0) { transpose_tile(a.in[6], 1024, 10272, r, 0, (bf16_t*)(ws + WS_WIN), (bf16_t*)(ws + WS_WDT), nullptr, ldsf); continue; } r -= nt0;
        if (r < nt1) { transpose_tile(a.in[15], 1024, 1024, r, 1, (bf16_t*)(ws + WS_WPA), nullptr, nullptr, ldsf); continue; } r -= nt1;
        if (r < nt2) { transpose_tile(a.in[22], 2048, 1024, r, 2, (bf16_t*)(ws + WS_WPB), nullptr, a.in[21], ldsf); continue; } r -= nt2;
        if (r < nt3) { transpose_tile(a.in[23], 1024, 1024, r, 3, (bf16_t*)(ws + WS_WOUT), nullptr, nullptr, ldsf); continue; } r -= nt3;
        if (r < nt4) { transpose_tile(a.in[26], 1024, 4096, r, 4, (bf16_t*)(ws + WS_WFF1), nullptr, nullptr, ldsf); continue; } r -= nt4;
        transpose_tile(a.in[27], 4096, 1024, r, 5, (bf16_t*)(ws + WS_WFF2), nullptr, nullptr, ldsf);
    }
    for (int idx = bid * NTHREADS + tid; idx < 2 * 65536; idx += gridDim.x * NTHREADS) {
        const int which = idx >> 16, e = idx & 65535, h = e >> 12, j = (e >> 6) & 63, i = e & 63;
        const float* src = which ? a.in[12] : a.in[10]; bf16_t* dst = (bf16_t*)(ws + (which ? WS_WXT : WS_WAT));
        dst[e] = f2bf(src[h * 4096 + i * 64 + j]);
    }
    __syncthreads();
    if (bid < 192) {
        const int jb = bid % 12, ks = bid / 12;
        float* cs = ldsf;
        for (int i = tid; i < 1024; i += NTHREADS) { const int b = i >> 6, k = i & 63; cs[i] = siluf_(a.in[1][b * 1024 + ks * 64 + k]); }
        __syncthreads();
        const int j = jb * 512 + tid;
        float acc[16];
#pragma unroll
        for (int b = 0; b < 16; ++b) acc[b] = 0.f;
        for (int k = 0; k < 64; ++k) { const float w = a.in[2][(size_t)(ks * 64 + k) * NMOD + j];
#pragma unroll
            for (int b = 0; b < 16; ++b) acc[b] += cs[b * 64 + k] * w; }
        float* mp = (float*)(ws + WS_MODP);
#pragma unroll
        for (int b = 0; b < 16; ++b) mp[((size_t)ks * 16 + b) * NMOD + j] = acc[b];
    }
}
__device__ void phase_mod_reduce(CArgs& a) {
    const float* mp = (const float*)(a.ws + WS_MODP); float* mod = (float*)(a.ws + WS_MOD);
    for (int idx = obid() * NTHREADS + otid(); idx < 16 * NMOD; idx += gridDim.x * NTHREADS) {
        const int j = idx % NMOD; float s = a.in[3][j];
        for (int ks = 0; ks < 16; ++ks) s += mp[(size_t)ks * 16 * NMOD + idx];
        mod[idx] = s;
    }
}

__device__ void phase_h1(CArgs& a, int g) {
    const int tid_ = otid(), lane = tid_ & 63, wv = obid() * 8 + (tid_ >> 6), nwv = gridDim.x * 8;
    const float* mod = (const float*)(a.ws + WS_MOD); bf16_t* H = (bf16_t*)(a.ws + WS_H);
    f32x4 nx[4];
    if (wv < TG) { const f32x4* xr = (const f32x4*)(a.in[0] + (size_t)(g * TG + wv) * 1024);
#pragma unroll
        for (int i = 0; i < 4; ++i) nx[i] = __builtin_nontemporal_load(xr + lane + 64 * i);     }
    for (int r = wv; r < TG; r += nwv) {
        const int tok = g * TG + r, b = tok / SEQ;
        f32x4 v[4]; float ss = 0.f;
#pragma unroll
        for (int i = 0; i < 4; ++i) { v[i] = nx[i]; ss += v[i][0] * v[i][0] + v[i][1] * v[i][1] + v[i][2] * v[i][2] + v[i][3] * v[i][3]; }
        if (r + nwv < TG) { const f32x4* xr = (const f32x4*)(a.in[0] + (size_t)(tok + nwv) * 1024);
#pragma unroll
            for (int i = 0; i < 4; ++i) nx[i] = __builtin_nontemporal_load(xr + lane + 64 * i);     }
        ss = wave_sum(ss, lane); const float rs = rsqrtf(ss * (1.0f / 1024.0f) + EPS);
#pragma unroll
        for (int i = 0; i < 4; ++i) { const int c = (lane + 64 * i) * 4;
            const f32x4 pw = *(const f32x4*)(a.in[4] + c), sh = *(const f32x4*)(mod + b * NMOD + c), sc = *(const f32x4*)(mod + b * NMOD + 1024 + c);
            f32x4 h;
#pragma unroll
            for (int j = 0; j < 4; ++j) h[j] = v[i][j] * rs * pw[j] * (1.0f + sc[j]) + sh[j];
            u32x2 w; w.x = pack2(h[0], h[1]); w.y = pack2(h[2], h[3]); *(u32x2*)(H + (size_t)r * 1024 + c) = w; }
    }
}

__device__ void phase_dt(CArgs& a) {
    const int tid_ = otid(), lane = tid_ & 63, wv = obid() * 8 + (tid_ >> 6), nwv = gridDim.x * 8, fr = lane & 15, fq = lane >> 4;
    const bf16_t* H = (const bf16_t*)(a.ws + WS_H); const bf16_t* W = (const bf16_t*)(a.ws + WS_WDT); float* DT = (float*)(a.ws + WS_DT);
    for (int tile = wv; tile < TG / 16; tile += nwv) {
        f32x4 c0 = {0.f, 0.f, 0.f, 0.f}, c1 = {0.f, 0.f, 0.f, 0.f};
        const bf16_t* ap = H + (size_t)(tile * 16 + fr) * 1024 + fq * 8; const bf16_t* bp0 = W + (size_t)fr * 1024 + fq * 8; const bf16_t* bp1 = W + (size_t)(16 + fr) * 1024 + fq * 8;
#pragma unroll 8
        for (int ks = 0; ks < 32; ++ks) {
            const bf16x8 av = *(const bf16x8*)(ap + ks * 32), b0 = *(const bf16x8*)(bp0 + ks * 32), b1 = *(const bf16x8*)(bp1 + ks * 32);
            c0 = __builtin_amdgcn_mfma_f32_16x16x32_bf16(av, b0, c0, 0, 0, 0);
            c1 = __builtin_amdgcn_mfma_f32_16x16x32_bf16(av, b1, c1, 0, 0, 0);
        }
        const float bi0 = a.in[18][fr], bi1 = a.in[18][16 + fr];
#pragma unroll
        for (int r = 0; r < 4; ++r) { const int t = tile * 16 + fq * 4 + r; DT[(size_t)t * 32 + fr] = softplusf_(c0[r] + bi0); DT[(size_t)t * 32 + 16 + fr] = softplusf_(c1[r] + bi1); }
    }
}

#define TR_ISSUE(dst, addr) asm volatile("ds_read_b64_tr_b16 %0, %1" : "=&v"(dst) : "v"(addr) : "memory")
__device__ __forceinline__ bf16x8 frag_of(u32x2 lo, u32x2 hi) { u32x4 w; w.x = lo.x; w.y = lo.y; w.z = hi.x; w.w = hi.y; return __builtin_bit_cast(bf16x8, w); }
__device__ __forceinline__ void unpack8(u32x4 w, float* f) { f[0] = bflo(w.x); f[1] = bfhi(w.x); f[2] = bflo(w.y); f[3] = bfhi(w.y); f[4] = bflo(w.z); f[5] = bfhi(w.z); f[6] = bflo(w.w); f[7] = bfhi(w.w); }

__device__ void phase_bcconv(CArgs& a, int g) {
    const int gt = obid() * NTHREADS + otid(), nth = gridDim.x * NTHREADS;
    const bf16_t* XBC = (const bf16_t*)(a.ws + WS_XBC); bf16_t* BCc = (bf16_t*)(a.out + (size_t)g * TG * 1024);
    const float* cw = a.in[16]; const float* cb = a.in[17];
    {
        const int cv = gt & 255, c0 = 2048 + cv * 8;
        float w0[8], w1[8], w2[8], w3[8], bs[8];
#pragma unroll
        for (int j = 0; j < 8; ++j) { w0[j] = cw[c0 + j]; w1[j] = cw[4096 + c0 + j]; w2[j] = cw[8192 + c0 + j]; w3[j] = cw[12288 + c0 + j]; bs[j] = cb[c0 + j]; }
        for (int run = gt >> 8; run < TG / 64; run += nth >> 8) {
            const size_t ts = (size_t)run * 64; const bool first = ((run & 63) == 0);
            float x0[8], x1[8], x2[8], x3[8];
#pragma unroll
            for (int j = 0; j < 8; ++j) { x0[j] = 0.f; x1[j] = 0.f; x2[j] = 0.f; }
            if (!first) { unpack8(*(const u32x4*)(XBC + (ts - 3) * 4096 + c0), x0); unpack8(*(const u32x4*)(XBC + (ts - 2) * 4096 + c0), x1); unpack8(*(const u32x4*)(XBC + (ts - 1) * 4096 + c0), x2); }
            for (int i0 = 0; i0 < 64; i0 += 8) {
                u32x4 raw[8];
#pragma unroll
                for (int i = 0; i < 8; ++i) raw[i] = *(const u32x4*)(XBC + (ts + i0 + i) * 4096 + c0);
#pragma unroll
                for (int i = 0; i < 8; ++i) {
                    unpack8(raw[i], x3);
                    float o[8];
#pragma unroll
                    for (int j = 0; j < 8; ++j) { o[j] = siluf_(bs[j] + w0[j] * x0[j] + w1[j] * x1[j] + w2[j] * x2[j] + w3[j] * x3[j]); x0[j] = x1[j]; x1[j] = x2[j]; x2[j] = x3[j]; }
                    u32x4 w; w.x = pack2(o[0], o[1]); w.y = pack2(o[2], o[3]); w.z = pack2(o[4], o[5]); w.w = pack2(o[6], o[7]);
                    *(u32x4*)(BCc + (ts + i0 + i) * 2048 + cv * 8) = w;
                }
            }
        }
    }
    {
        const float* DT = (const float*)(a.ws + WS_DT); float* CS = (float*)(a.ws + WS_CS);
        for (int idx = gt; idx < BG * 64 * 32; idx += nth) {
            const int hh = idx & 31; const size_t t0 = (size_t)(idx >> 5) * 64; const float Ah = -expf(a.in[19][hh]); float run = 0.f;
            for (int i0 = 0; i0 < 64; i0 += 16) { float d[16];
#pragma unroll
                for (int i = 0; i < 16; ++i) d[i] = DT[(t0 + i0 + i) * 32 + hh];
#pragma unroll
                for (int i = 0; i < 16; ++i) { run += d[i] * Ah; CS[(t0 + i0 + i) * 32 + hh] = run; } }
        }
    }
}

__device__ void phase_ssd(CArgs& a, int g, unsigned char* lds) {
    const int tid0 = otid();
    constexpr int OFF_C = 0, OFF_B = 17408, OFF_S = 34816, OFF_X = 52224, OFF_XW = 61440, OFF_G = 70656, OFF_Y = 79872, OFF_CS = 97280, OFF_DT = 97536;
    const unsigned lb = (unsigned)(size_t)lds;
    float* Ys = (float*)(lds + OFF_Y); float* css = (float*)(lds + OFF_CS); float* dts = (float*)(lds + OFF_DT);
    const bf16_t* XBC = (const bf16_t*)(a.ws + WS_XBC); const bf16_t* Z = (const bf16_t*)(a.ws + WS_Z); bf16_t* YB = (bf16_t*)(a.ws + WS_YB);
    const bf16_t* BCc = (const bf16_t*)(a.out + (size_t)g * TG * 1024);
    const float* DT = (const float*)(a.ws + WS_DT); const float* CS = (const float*)(a.ws + WS_CS); const float* cw = a.in[16]; const float* cb = a.in[17];
    for (int unit0 = obid(); unit0 < BG * 32; unit0 += gridDim.x) {
        const int unit = (gridDim.x == 256) ? ((unit0 & 7) * 32 + (unit0 >> 3)) : unit0;
        const int bl = unit >> 5, h = unit & 31, grp = h >> 2;
        const float Dh = a.in[20][h];
        const int sc0w = h * 64 + (tid0 & 7) * 8;
        float w0[8], w1[8], w2[8], w3[8], bs[8];
#pragma unroll
        for (int j = 0; j < 8; ++j) { const int sc0 = sc0w; w0[j] = cw[sc0 + j]; w1[j] = cw[4096 + sc0 + j]; w2[j] = cw[8192 + sc0 + j]; w3[j] = cw[12288 + sc0 + j]; bs[j] = cb[sc0 + j]; }
        f32x4 accs[4];
#pragma unroll
        for (int i = 0; i < 4; ++i) accs[i] = (f32x4){0.f, 0.f, 0.f, 0.f};
        __syncthreads();
        for (int i = tid0; i < 1088; i += NTHREADS) *(u32x4*)(lds + OFF_S + i * 16) = (u32x4){0u, 0u, 0u, 0u};
        u32x4 px[4], pbc[4], pz; float pdt, pcs, pce;
#define SSD_PREFETCH(B_) do { const int b_ = (B_); const int tidp = otid(), ptok = tidp >> 3, pcv = tidp & 7; const size_t tp0 = (size_t)bl * SEQ + b_ * 64; \
        _Pragma("unroll") for (int k = 0; k < 4; ++k) { const int sp = b_ * 64 + ptok - 3 + k; \
            px[k] = (sp >= 0) ? *(const u32x4*)(XBC + ((size_t)bl * SEQ + sp) * 4096 + h * 64 + pcv * 8) : (u32x4){0u, 0u, 0u, 0u}; } \
        pdt = DT[(tp0 + ptok) * 32 + h]; pcs = CS[(tp0 + ptok) * 32 + h]; pce = CS[(tp0 + 63) * 32 + h]; \
        pz = *(const u32x4*)(Z + (tp0 + ptok) * 2048 + h * 64 + pcv * 8); \
        _Pragma("unroll") for (int i = 0; i < 4; ++i) { const int idx = tidp + 512 * i, which = idx >> 10, rem = idx & 1023, row = rem >> 4, ch = rem & 15; \
            pbc[i] = *(const u32x4*)(BCc + (tp0 + row) * 2048 + which * 1024 + grp * 128 + ch * 8); } } while (0)
        SSD_PREFETCH(0);
        for (int blk = 0; blk < SEQ / 64; ++blk) {
            const size_t t0 = (size_t)bl * SEQ + blk * 64;
            const int tid = otid(), lane = tid & 63, wid = __builtin_amdgcn_readfirstlane(tid >> 6), fr = lane & 15, fq = lane >> 4, tq = (lane & 15) >> 2, tp = lane & 3;
            const int stok = tid >> 3, scv = tid & 7;
            const u32x4 zcur = pz;
            {
                float xr[4][8];
#pragma unroll
                for (int k = 0; k < 4; ++k) unpack8(px[k], xr[k]);
                const float dtv = pdt, csv = pcs, cse = pce, wgt = dtv * __expf(cse - csv);
                float o[8];
#pragma unroll
                for (int j = 0; j < 8; ++j) o[j] = siluf_(bs[j] + w0[j] * xr[0][j] + w1[j] * xr[1][j] + w2[j] * xr[2][j] + w3[j] * xr[3][j]);
                u32x4 w; w.x = pack2(o[0], o[1]); w.y = pack2(o[2], o[3]); w.z = pack2(o[4], o[5]); w.w = pack2(o[6], o[7]);
                *(u32x4*)(lds + OFF_X + stok * 144 + scv * 16) = w;
                w.x = pack2(o[0] * wgt, o[1] * wgt); w.y = pack2(o[2] * wgt, o[3] * wgt); w.z = pack2(o[4] * wgt, o[5] * wgt); w.w = pack2(o[6] * wgt, o[7] * wgt);
                *(u32x4*)(lds + OFF_XW + stok * 144 + scv * 16) = w;
                if (scv == 0) { css[stok] = csv; dts[stok] = dtv; }
#pragma unroll
                for (int i = 0; i < 4; ++i) { const int idx = tid + 512 * i, which = idx >> 10, rem = idx & 1023, row = rem >> 4, ch = rem & 15;
                    *(u32x4*)(lds + (which ? OFF_C : OFF_B) + row * 272 + ch * 16) = pbc[i]; }
            }
            if (blk + 1 < SEQ / 64) SSD_PREFETCH(blk + 1);
            __syncthreads();
            const int li = wid >> 1, si0 = (wid * 2) & 3, si1 = si0 + 1;
            bf16x8 cfr[4], avA[4], avB[4];
#pragma unroll
            for (int ks = 0; ks < 4; ++ks) { cfr[ks] = *(const bf16x8*)(lds + OFF_C + (li * 16 + fr) * 272 + ks * 64 + fq * 16);
                avA[ks] = *(const bf16x8*)(lds + OFF_B + (si0 * 16 + fr) * 272 + ks * 64 + fq * 16); avB[ks] = *(const bf16x8*)(lds + OFF_B + (si1 * 16 + fr) * 272 + ks * 64 + fq * 16); }
            const float csl = css[li * 16 + fr];
            const f32x4 csA = *(const f32x4*)(css + si0 * 16 + fq * 4), dtA = *(const f32x4*)(dts + si0 * 16 + fq * 4), csB = *(const f32x4*)(css + si1 * 16 + fq * 4), dtB = *(const f32x4*)(dts + si1 * 16 + fq * 4);
            {
                u32x2 gwA = {0u, 0u}, gwB = {0u, 0u}; const int l = li * 16 + fr;
                if (si0 <= li) { f32x4 acc = {0.f, 0.f, 0.f, 0.f};
#pragma unroll
                    for (int ks = 0; ks < 4; ++ks) acc = __builtin_amdgcn_mfma_f32_16x16x32_bf16(avA[ks], cfr[ks], acc, 0, 0, 0);
                    float gv[4];
#pragma unroll
                    for (int r = 0; r < 4; ++r) { const int sidx = si0 * 16 + fq * 4 + r; gv[r] = (sidx <= l) ? acc[r] * __expf(csl - csA[r]) * dtA[r] : 0.f; }
                    gwA.x = pack2(gv[0], gv[1]); gwA.y = pack2(gv[2], gv[3]); }
                if (si1 <= li) { f32x4 acc = {0.f, 0.f, 0.f, 0.f};
#pragma unroll
                    for (int ks = 0; ks < 4; ++ks) acc = __builtin_amdgcn_mfma_f32_16x16x32_bf16(avB[ks], cfr[ks], acc, 0, 0, 0);
                    float gv[4];
#pragma unroll
                    for (int r = 0; r < 4; ++r) { const int sidx = si1 * 16 + fq * 4 + r; gv[r] = (sidx <= l) ? acc[r] * __expf(csl - csB[r]) * dtB[r] : 0.f; }
                    gwB.x = pack2(gv[0], gv[1]); gwB.y = pack2(gv[2], gv[3]); }
                *(u32x2*)(lds + OFF_G + (li * 16 + fr) * 144 + (si0 * 16 + fq * 4) * 2) = gwA;
                *(u32x2*)(lds + OFF_G + (li * 16 + fr) * 144 + (si1 * 16 + fq * 4) * 2) = gwB;
            }
            __syncthreads();
            {
                const int pi0 = (wid * 2) & 3;
                const bf16x8 g0 = *(const bf16x8*)(lds + OFF_G + (li * 16 + fr) * 144 + fq * 16), g1 = *(const bf16x8*)(lds + OFF_G + (li * 16 + fr) * 144 + 64 + fq * 16);
                const f32x4 csl4 = *(const f32x4*)(css + li * 16 + fq * 4); const float cs63 = css[63];
                bf16x8 svA[4], svB[4];
#pragma unroll
                for (int ks = 0; ks < 4; ++ks) { svA[ks] = *(const bf16x8*)(lds + OFF_S + (pi0 * 16 + fr) * 272 + ks * 64 + fq * 16); svB[ks] = *(const bf16x8*)(lds + OFF_S + ((pi0 + 1) * 16 + fr) * 272 + ks * 64 + fq * 16); }
                bf16_t xsA[4], xsB[4];
#pragma unroll
                for (int r = 0; r < 4; ++r) { xsA[r] = *(const bf16_t*)(lds + OFF_X + (li * 16 + fq * 4 + r) * 144 + (pi0 * 16 + fr) * 2); xsB[r] = *(const bf16_t*)(lds + OFF_X + (li * 16 + fq * 4 + r) * 144 + ((pi0 + 1) * 16 + fr) * 2); }
                u32x2 xa0, xa1, xa2, xa3, xb0, xb1, xb2, xb3;
                {   const unsigned xa = lb + OFF_X + (8 * fq + tq) * 144 + (pi0 * 16 + 4 * tp) * 2, xb = xa + 32;
                    TR_ISSUE(xa0, xa); TR_ISSUE(xa1, xa + 4 * 144); TR_ISSUE(xa2, xa + 32 * 144); TR_ISSUE(xa3, xa + 36 * 144);
                    TR_ISSUE(xb0, xb); TR_ISSUE(xb1, xb + 4 * 144); TR_ISSUE(xb2, xb + 32 * 144); TR_ISSUE(xb3, xb + 36 * 144); }
                asm volatile("s_waitcnt lgkmcnt(0)" : "+v"(xa0), "+v"(xa1), "+v"(xa2), "+v"(xa3), "+v"(xb0), "+v"(xb1), "+v"(xb2), "+v"(xb3) :: "memory");
                f32x4 adA = {0.f, 0.f, 0.f, 0.f}, aoA = {0.f, 0.f, 0.f, 0.f}, adB = {0.f, 0.f, 0.f, 0.f}, aoB = {0.f, 0.f, 0.f, 0.f};
                adA = __builtin_amdgcn_mfma_f32_16x16x32_bf16(g0, frag_of(xa0, xa1), adA, 0, 0, 0); adB = __builtin_amdgcn_mfma_f32_16x16x32_bf16(g0, frag_of(xb0, xb1), adB, 0, 0, 0);
                if (li >= 2) { adA = __builtin_amdgcn_mfma_f32_16x16x32_bf16(g1, frag_of(xa2, xa3), adA, 0, 0, 0); adB = __builtin_amdgcn_mfma_f32_16x16x32_bf16(g1, frag_of(xb2, xb3), adB, 0, 0, 0); }
#pragma unroll
                for (int ks = 0; ks < 4; ++ks) { aoA = __builtin_amdgcn_mfma_f32_16x16x32_bf16(cfr[ks], svA[ks], aoA, 0, 0, 0); aoB = __builtin_amdgcn_mfma_f32_16x16x32_bf16(cfr[ks], svB[ks], aoB, 0, 0, 0); }
                u32x2 b0, b1, b2, b3, q0, q1, q2, q3, q4, q5, q6, q7, r0, r1, r2, r3, r4, r5, r6, r7;
                {   const unsigned ba = lb + OFF_B + (8 * fq + tq) * 272 + (wid * 16 + 4 * tp) * 2, qa = lb + OFF_XW + (8 * fq + tq) * 144 + (4 * tp) * 2, qb = qa + 32 * 144;
                    TR_ISSUE(b0, ba); TR_ISSUE(b1, ba + 4 * 272); TR_ISSUE(b2, ba + 32 * 272); TR_ISSUE(b3, ba + 36 * 272);
                    TR_ISSUE(q0, qa); TR_ISSUE(q1, qa + 4 * 144); TR_ISSUE(q2, qa + 32); TR_ISSUE(q3, qa + 32 + 4 * 144);
                    TR_ISSUE(q4, qa + 64); TR_ISSUE(q5, qa + 64 + 4 * 144); TR_ISSUE(q6, qa + 96); TR_ISSUE(q7, qa + 96 + 4 * 144);
                    TR_ISSUE(r0, qb); TR_ISSUE(r1, qb + 4 * 144); TR_ISSUE(r2, qb + 32); TR_ISSUE(r3, qb + 32 + 4 * 144);
                    TR_ISSUE(r4, qb + 64); TR_ISSUE(r5, qb + 64 + 4 * 144); TR_ISSUE(r6, qb + 96); TR_ISSUE(r7, qb + 96 + 4 * 144); }
                float yA[4], yB[4];
#pragma unroll
                for (int r = 0; r < 4; ++r) { const float e = __expf(csl4[r]); yA[r] = adA[r] + e * aoA[r] + Dh * bf2f(xsA[r]); yB[r] = adB[r] + e * aoB[r] + Dh * bf2f(xsB[r]); }
                asm volatile("s_waitcnt lgkmcnt(0)" : "+v"(b0), "+v"(b1), "+v"(b2), "+v"(b3), "+v"(q0), "+v"(q1), "+v"(q2), "+v"(q3), "+v"(q4), "+v"(q5), "+v"(q6), "+v"(q7) :: "memory");
                asm volatile("" : "+v"(r0), "+v"(r1), "+v"(r2), "+v"(r3), "+v"(r4), "+v"(r5), "+v"(r6), "+v"(r7) :: "memory");
                const float dec = __expf(cs63);
#pragma unroll
                for (int pt = 0; pt < 4; ++pt) accs[pt] *= dec;
                {   const bf16x8 bf0 = frag_of(b0, b1), bf1 = frag_of(b2, b3);
                    accs[0] = __builtin_amdgcn_mfma_f32_16x16x32_bf16(bf0, frag_of(q0, q1), accs[0], 0, 0, 0);
                    accs[1] = __builtin_amdgcn_mfma_f32_16x16x32_bf16(bf0, frag_of(q2, q3), accs[1], 0, 0, 0);
                    accs[2] = __builtin_amdgcn_mfma_f32_16x16x32_bf16(bf0, frag_of(q4, q5), accs[2], 0, 0, 0);
                    accs[3] = __builtin_amdgcn_mfma_f32_16x16x32_bf16(bf0, frag_of(q6, q7), accs[3], 0, 0, 0);
                    accs[0] = __builtin_amdgcn_mfma_f32_16x16x32_bf16(bf1, frag_of(r0, r1), accs[0], 0, 0, 0);
                    accs[1] = __builtin_amdgcn_mfma_f32_16x16x32_bf16(bf1, frag_of(r2, r3), accs[1], 0, 0, 0);
                    accs[2] = __builtin_amdgcn_mfma_f32_16x16x32_bf16(bf1, frag_of(r4, r5), accs[2], 0, 0, 0);
                    accs[3] = __builtin_amdgcn_mfma_f32_16x16x32_bf16(bf1, frag_of(r6, r7), accs[3], 0, 0, 0); }
#pragma unroll
                for (int r = 0; r < 4; ++r) { const int l = li * 16 + fq * 4 + r; Ys[l * 68 + pi0 * 16 + fr] = yA[r]; Ys[l * 68 + (pi0 + 1) * 16 + fr] = yB[r]; }
            }
            __syncthreads();
#pragma unroll
            for (int pt = 0; pt < 4; ++pt) { u32x2 w; w.x = pack2(accs[pt][0], accs[pt][1]); w.y = pack2(accs[pt][2], accs[pt][3]);
                *(u32x2*)(lds + OFF_S + (pt * 16 + fr) * 272 + (wid * 16 + fq * 4) * 2) = w; }
            {   const f32x4 y0 = *(const f32x4*)(Ys + stok * 68 + scv * 8), y1 = *(const f32x4*)(Ys + stok * 68 + scv * 8 + 4);
                u32x4 w; w.x = pack2(y0[0] * bflo(zcur.x), y0[1] * bfhi(zcur.x)); w.y = pack2(y0[2] * bflo(zcur.y), y0[3] * bfhi(zcur.y));
                w.z = pack2(y1[0] * bflo(zcur.z), y1[1] * bfhi(zcur.z)); w.w = pack2(y1[2] * bflo(zcur.w), y1[3] * bfhi(zcur.w));
                *(u32x4*)(YB + (t0 + stok) * 2048 + h * 64 + scv * 8) = w; }
        }
#undef SSD_PREFETCH
    }
}

__device__ void phase_lru(CArgs& a, unsigned char* lds) {
    const int tid = otid(), lane = tid & 63, wid = __builtin_amdgcn_readfirstlane(tid >> 6), fr = lane & 15, fq = lane >> 4;
    bf16_t* XCb = (bf16_t*)lds;
    float* XCf = (float*)(lds + 9216);
    float* SP = XCf + 64 * 68; float* SH = SP + 512;
    const bf16_t* LX = (const bf16_t*)(a.ws + WS_LX); const bf16_t* LG = (const bf16_t*)(a.ws + WS_LG); bf16_t* YA = (bf16_t*)(a.ws + WS_H);
    const bf16_t* WAT = (const bf16_t*)(a.ws + WS_WAT); const bf16_t* WXT = (const bf16_t*)(a.ws + WS_WXT);
    const float* cw = a.in[8]; const float* cb = a.in[9];
    for (int unit = obid(); unit < BG * 32; unit += gridDim.x) {
        const int bl = unit >> 5, h = (unit >> 1) & 15, jh = unit & 1;
        const int stok = tid >> 3, scv = tid & 7, sc0 = h * 64 + scv * 8;
        float w0[8], w1[8], w2[8], w3[8], bs[8];
#pragma unroll
        for (int j = 0; j < 8; ++j) { w0[j] = cw[sc0 + j]; w1[j] = cw[1024 + sc0 + j]; w2[j] = cw[2048 + sc0 + j]; w3[j] = cw[3072 + sc0 + j]; bs[j] = cb[sc0 + j]; }
        const int tt = wid & 3, nt = wid >> 2, jj = nt * 16 + fr, chg = h * 64 + jh * 32 + jj, seg = tt * 4 + fq;
        const size_t wo = (size_t)h * 4096 + (size_t)(jh * 32 + jj) * 64 + fq * 8;
        const bf16x8 wa0 = *(const bf16x8*)(WAT + wo), wa1 = *(const bf16x8*)(WAT + wo + 32), wx0 = *(const bf16x8*)(WXT + wo), wx1 = *(const bf16x8*)(WXT + wo + 32);
        const float bav = a.in[11][chg], bxv = a.in[13][chg], spv = softplusf_(-a.in[14][chg]);
        float hc = 0.f;
        u32x4 px[4];
#define LRU_PREFETCH(B_) do { const int b_ = (B_); _Pragma("unroll") for (int k = 0; k < 4; ++k) { const int sp = b_ * 64 + stok - 3 + k; \
        px[k] = (sp >= 0) ? *(const u32x4*)(LX + ((size_t)bl * SEQ + sp) * 1024 + sc0) : (u32x4){0u, 0u, 0u, 0u}; } } while (0)
        LRU_PREFETCH(0);
        __syncthreads();
        for (int blk = 0; blk < SEQ / 64; ++blk) {
            const size_t t0 = (size_t)bl * SEQ + blk * 64;
            {
                float xr[4][8];
#pragma unroll
                for (int k = 0; k < 4; ++k) unpack8(px[k], xr[k]);
                float o[8];
#pragma unroll
                for (int j = 0; j < 8; ++j) o[j] = bs[j] + w0[j] * xr[0][j] + w1[j] * xr[1][j] + w2[j] * xr[2][j] + w3[j] * xr[3][j];
                u32x4 w; w.x = pack2(o[0], o[1]); w.y = pack2(o[2], o[3]); w.z = pack2(o[4], o[5]); w.w = pack2(o[6], o[7]);
                *(u32x4*)(XCb + stok * 72 + scv * 8) = w;
                *(f32x4*)(XCf + stok * 68 + scv * 8) = (f32x4){o[0], o[1], o[2], o[3]}; *(f32x4*)(XCf + stok * 68 + scv * 8 + 4) = (f32x4){o[4], o[5], o[6], o[7]};
            }
            bf16_t lgv[4];
#pragma unroll
            for (int r = 0; r < 4; ++r) lgv[r] = LG[(t0 + tt * 16 + fq * 4 + r) * 1024 + chg];
            if (blk + 1 < SEQ / 64) LRU_PREFETCH(blk + 1);
            __syncthreads();
            f32x4 cr = {0.f, 0.f, 0.f, 0.f}, ci = {0.f, 0.f, 0.f, 0.f};
            {   const bf16x8 a0 = *(const bf16x8*)(XCb + (tt * 16 + fr) * 72 + fq * 8), a1 = *(const bf16x8*)(XCb + (tt * 16 + fr) * 72 + 32 + fq * 8);
                cr = __builtin_amdgcn_mfma_f32_16x16x32_bf16(a0, wa0, cr, 0, 0, 0); cr = __builtin_amdgcn_mfma_f32_16x16x32_bf16(a1, wa1, cr, 0, 0, 0);
                ci = __builtin_amdgcn_mfma_f32_16x16x32_bf16(a0, wx0, ci, 0, 0, 0); ci = __builtin_amdgcn_mfma_f32_16x16x32_bf16(a1, wx1, ci, 0, 0, 0); }
            float hl[4], cp[4];
#pragma unroll
            for (int r = 0; r < 4; ++r) { const int tok = tt * 16 + fq * 4 + r;
                const float rr = sigmoidf_(cr[r] + bav), ii = sigmoidf_(ci[r] + bxv);
                const float la = -8.0f * rr * spv, av = __expf(la), uv = __builtin_amdgcn_sqrtf(fmaxf(1.0f - av * av, 0.f)) * ii * XCf[tok * 68 + jh * 32 + jj];
                if (r == 0) { hl[0] = uv; cp[0] = av; } else { hl[r] = av * hl[r - 1] + uv; cp[r] = cp[r - 1] * av; } }
            SP[seg * 32 + jj] = cp[3]; SH[seg * 32 + jj] = hl[3];
            __syncthreads();
            float c = hc, mine = 0.f;
#pragma unroll
            for (int s2 = 0; s2 < 16; ++s2) { if (s2 == seg) mine = c; c = SP[s2 * 32 + jj] * c + SH[s2 * 32 + jj]; }
            hc = c;
#pragma unroll
            for (int r = 0; r < 4; ++r) { const float hv = hl[r] + cp[r] * mine; YA[(t0 + tt * 16 + fq * 4 + r) * 1024 + chg] = f2bf(hv * geluf_(bf2f(lgv[r]))); }
        }
    }
}


__device__ void phase_gnorm(CArgs& a) {
    const int tid_ = otid(), lane = tid_ & 63, wv = obid() * 8 + (tid_ >> 6), nwv = gridDim.x * 8;
    bf16_t* YB = (bf16_t*)(a.ws + WS_YB);
    for (int item = wv; item < TG * 8; item += 16 * nwv) {
        u32x2 w[16];
#pragma unroll
        for (int k = 0; k < 16; ++k) w[k] = (item + k * nwv < TG * 8) ? *(const u32x2*)(YB + (size_t)(item + k * nwv) * 256 + lane * 4) : (u32x2){0u, 0u};
#pragma unroll
        for (int k = 0; k < 16; ++k) {
            const float f0 = bflo(w[k].x), f1 = bfhi(w[k].x), f2 = bflo(w[k].y), f3 = bfhi(w[k].y);
            const float ss = wave_sum(f0 * f0 + f1 * f1 + f2 * f2 + f3 * f3, lane), rs = rsqrtf(ss * (1.0f / 256.0f) + EPS);
            u32x2 o; o.x = pack2(f0 * rs, f1 * rs); o.y = pack2(f2 * rs, f3 * rs); if (item + k * nwv < TG * 8) *(u32x2*)(YB + (size_t)(item + k * nwv) * 256 + lane * 4) = o; }
    }
}

__device__ void phase_mid(CArgs& a, int g) {
    const int tid_ = otid(), lane = tid_ & 63, wv = obid() * 8 + (tid_ >> 6), nwv = gridDim.x * 8;
    const float* mod = (const float*)(a.ws + WS_MOD); bf16_t* H = (bf16_t*)(a.ws + WS_H); const bf16_t* Y1 = (const bf16_t*)(a.ws + WS_XBC + (size_t)TG * 1024 * 4);
    bf16_t* X2 = (bf16_t*)(a.ws + WS_LG);
    u32x2 ny[4]; f32x4 nx[4];
    if (wv < TG) { const u32x2* yr = (const u32x2*)(Y1 + (size_t)wv * 1024); const f32x4* xr = (const f32x4*)(a.in[0] + (size_t)(g * TG + wv) * 1024);
#pragma unroll
        for (int i = 0; i < 4; ++i) { ny[i] = yr[lane + 64 * i]; nx[i] = __builtin_nontemporal_load(xr + lane + 64 * i); } }
    for (int r = wv; r < TG; r += nwv) {
        const int tok = g * TG + r, b = tok / SEQ;
        f32x4 y[4], xv[4]; float ss = 0.f;
#pragma unroll
        for (int i = 0; i < 4; ++i) { const u32x2 yw = ny[i]; xv[i] = nx[i]; y[i] = (f32x4){bflo(yw.x), bfhi(yw.x), bflo(yw.y), bfhi(yw.y)}; ss += y[i][0] * y[i][0] + y[i][1] * y[i][1] + y[i][2] * y[i][2] + y[i][3] * y[i][3]; }
        if (r + nwv < TG) { const u32x2* yr = (const u32x2*)(Y1 + (size_t)(r + nwv) * 1024); const f32x4* xr = (const f32x4*)(a.in[0] + (size_t)(tok + nwv) * 1024);
#pragma unroll
            for (int i = 0; i < 4; ++i) { ny[i] = yr[lane + 64 * i]; nx[i] = __builtin_nontemporal_load(xr + lane + 64 * i); } }
        ss = wave_sum(ss, lane); const float rs = rsqrtf(ss * (1.0f / 1024.0f) + EPS);
        float ss2 = 0.f;
#pragma unroll
        for (int i = 0; i < 4; ++i) { const int c = (lane + 64 * i) * 4; const f32x4 pw = *(const f32x4*)(a.in[5] + c), g1 = *(const f32x4*)(mod + b * NMOD + 2048 + c);
#pragma unroll
            for (int j = 0; j < 4; ++j) { y[i][j] = xv[i][j] + g1[j] * (y[i][j] * rs * pw[j]); ss2 += y[i][j] * y[i][j]; }
            { u32x2 w; w.x = pack2(y[i][0], y[i][1]); w.y = pack2(y[i][2], y[i][3]); *(u32x2*)(X2 + (size_t)r * 1024 + c) = w; } }
        ss2 = wave_sum(ss2, lane); const float rs2 = rsqrtf(ss2 * (1.0f / 1024.0f) + EPS);
#pragma unroll
        for (int i = 0; i < 4; ++i) { const int c = (lane + 64 * i) * 4;
            const f32x4 pw = *(const f32x4*)(a.in[24] + c), sh = *(const f32x4*)(mod + b * NMOD + 3072 + c), sc = *(const f32x4*)(mod + b * NMOD + 4096 + c);
            u32x2 w; w.x = pack2(y[i][0] * rs2 * pw[0] * (1.0f + sc[0]) + sh[0], y[i][1] * rs2 * pw[1] * (1.0f + sc[1]) + sh[1]);
            w.y = pack2(y[i][2] * rs2 * pw[2] * (1.0f + sc[2]) + sh[2], y[i][3] * rs2 * pw[3] * (1.0f + sc[3]) + sh[3]);
            *(u32x2*)(H + (size_t)r * 1024 + c) = w; }
    }
}

__device__ void phase_final(CArgs& a, int g) {
    const int tid_ = otid(), lane = tid_ & 63, wv = obid() * 8 + (tid_ >> 6), nwv = gridDim.x * 8;
    const float* mod = (const float*)(a.ws + WS_MOD); const bf16_t* Y2 = (const bf16_t*)(a.ws + WS_Z); const bf16_t* X2 = (const bf16_t*)(a.ws + WS_LG);
    u32x2 ny[4], nx[4];
    if (wv < TG) { const u32x2* yr = (const u32x2*)(Y2 + (size_t)wv * 1024); const u32x2* xr = (const u32x2*)(X2 + (size_t)wv * 1024);
#pragma unroll
        for (int i = 0; i < 4; ++i) { ny[i] = yr[lane + 64 * i]; nx[i] = xr[lane + 64 * i]; } }
    for (int r = wv; r < TG; r += nwv) {
        const int tok = g * TG + r, b = tok / SEQ;
        f32x4 y[4], xv[4]; float ss = 0.f;
#pragma unroll
        for (int i = 0; i < 4; ++i) { const u32x2 yw = ny[i], xw = nx[i]; xv[i] = (f32x4){bflo(xw.x), bfhi(xw.x), bflo(xw.y), bfhi(xw.y)}; y[i] = (f32x4){bflo(yw.x), bfhi(yw.x), bflo(yw.y), bfhi(yw.y)};
            ss += y[i][0] * y[i][0] + y[i][1] * y[i][1] + y[i][2] * y[i][2] + y[i][3] * y[i][3]; }
        if (r + nwv < TG) { const u32x2* yr = (const u32x2*)(Y2 + (size_t)(r + nwv) * 1024); const u32x2* xr = (const u32x2*)(X2 + (size_t)(r + nwv) * 1024);
#pragma unroll
            for (int i = 0; i < 4; ++i) { ny[i] = yr[lane + 64 * i]; nx[i] = xr[lane + 64 * i]; } }
        ss = wave_sum(ss, lane); const float rs = rsqrtf(ss * (1.0f / 1024.0f) + EPS);
#pragma unroll
        for (int i = 0; i < 4; ++i) { const int c = (lane + 64 * i) * 4; const f32x4 pw = *(const f32x4*)(a.in[25] + c), g2 = *(const f32x4*)(mod + b * NMOD + 5120 + c);
#pragma unroll
            for (int j = 0; j < 4; ++j) xv[i][j] += g2[j] * (y[i][j] * rs * pw[j]);
            __builtin_nontemporal_store(xv[i], (f32x4*)(a.out + (size_t)tok * 1024 + c)); }
    }
}

__global__ void __launch_bounds__(NTHREADS, 2) fwd_megakernel(Args a_unused) {
    extern __shared__ __attribute__((aligned(16))) unsigned char lds[];
    cg::grid_group grid = cg::this_grid();
    CArgs* ap0 = (CArgs*)__builtin_amdgcn_kernarg_segment_ptr();
#define AA (*launder(ap0))
    const int G = gridDim.x, bid = obid();
    LAS unsigned char* ldsl = (LAS unsigned char*)lds;

    volatile LAS unsigned* xst = (volatile LAS unsigned*)(ldsl + 131072);
    if (threadIdx.x < 4) xst[threadIdx.x] = 0u;
    __syncthreads();
    const XcdBarrier xb = xcd_barrier_post((unsigned*)(AA.ws + WS_BAR), xst);
    phase_prep(AA, (float*)lds);
    {   int never = 0; asm volatile("" : "+s"(never));
        if (never) grid.sync();
        xcd_barrier(xb); }
    phase_mod_reduce(AA);
    xcd_barrier(xb);

    for (int g = 0; g < NB; ++g) {
        phase_h1(AA, g);
        xcd_barrier(xb);
        phase_dt(AA);
        {   pg8::Gemm gm{(const bf16_t*)(AA.ws + WS_H), (const bf16_t*)(AA.ws + WS_WIN), TG, NIN, 1024}; pg8::StaticOrder S; S.init(TG, NIN, G, bid, 1);
            EpiIn E{(bf16_t*)(AA.ws + WS_LX), (bf16_t*)(AA.ws + WS_LG), (bf16_t*)(AA.ws + WS_Z), (bf16_t*)(AA.ws + WS_XBC), (bf16_t*)(AA.ws + WS_GT)};
            pg8::gemm_phase<EpiIn>(ldsl, gm, S, E); }
        xcd_barrier(xb);
        phase_bcconv(AA, g);
        phase_lru(AA, lds);
        xcd_barrier(xb);
        phase_ssd(AA, g, lds);
        xcd_barrier(xb);
        phase_gnorm(AA);
        xcd_barrier(xb);
        {   pg8::StaticOrder S; S.init(TG, 1024, G, bid);
            pg8::Gemm g1{(const bf16_t*)(AA.ws + WS_H), (const bf16_t*)(AA.ws + WS_WPA), TG, 1024, 1024};
            EpiPa E1{(bf16_t*)(AA.ws + WS_XBC), (const bf16_t*)(AA.ws + WS_GT), AA.in[7]};
            pg8::gemm_phase<EpiPa>(ldsl, g1, S, E1);
            pg8::Gemm g2{(const bf16_t*)(AA.ws + WS_YB), (const bf16_t*)(AA.ws + WS_WPB), TG, 1024, 2048};
            EpiPb E2{(const bf16_t*)(AA.ws + WS_XBC), (const bf16_t*)(AA.ws + WS_GT), (bf16_t*)(AA.ws + WS_LX), AA.in[7]};
            pg8::gemm_phase<EpiPb>(ldsl, g2, S, E2); }
        xcd_barrier(xb);
        {   pg8::StaticOrder S; S.init(TG, 1024, G, bid);
            pg8::Gemm g3{(const bf16_t*)(AA.ws + WS_LX), (const bf16_t*)(AA.ws + WS_WOUT), TG, 1024, 1024};
            EpiBf E{(bf16_t*)(AA.ws + WS_XBC + (size_t)TG * 1024 * 4), 1024};
            pg8::gemm_phase<EpiBf>(ldsl, g3, S, E); }
        xcd_barrier(xb);
        phase_mid(AA, g);
        xcd_barrier(xb);
        {   pg8::StaticOrder S; S.init(TG, 4096, G, bid);
            pg8::Gemm g4{(const bf16_t*)(AA.ws + WS_H), (const bf16_t*)(AA.ws + WS_WFF1), TG, 4096, 1024};
            EpiRelu2 E{(bf16_t*)(AA.ws + WS_XBC), 4096};
            pg8::gemm_phase<EpiRelu2>(ldsl, g4, S, E); }
        xcd_barrier(xb);
        {   pg8::StaticOrder S; S.init(TG, 1024, G, bid);
            pg8::Gemm g5{(const bf16_t*)(AA.ws + WS_XBC), (const bf16_t*)(AA.ws + WS_WFF2), TG, 1024, 4096};
            EpiBf E{(bf16_t*)(AA.ws + WS_Z), 1024};
            pg8::gemm_phase<EpiBf>(ldsl, g5, S, E); }
        xcd_barrier(xb);
        phase_final(AA, g);
    }
}

extern "C" void kernel_launch(void* const* d_in, const int* in_sizes, int n_in, void* d_out, int out_size, void* d_ws, size_t ws_size, hipStream_t stream) {
    static int grid_blocks = 0;
    if (!grid_blocks) {
        int dev = 0, cus = 0, per_cu = 0;
        hipGetDevice(&dev);
        hipDeviceGetAttribute(&cus, hipDeviceAttributeMultiprocessorCount, dev);
        hipFuncSetAttribute((const void*)fwd_megakernel, hipFuncAttributeMaxDynamicSharedMemorySize, LDS_BYTES);
        hipOccupancyMaxActiveBlocksPerMultiprocessor(&per_cu, (const void*)fwd_megakernel, NTHREADS, LDS_BYTES);
        if (per_cu < 1) per_cu = 1;
        grid_blocks = cus * per_cu;
        if (ws_size < WS_END) fprintf(stderr, "kernel_launch: workspace too small: %zu < %zu\n", ws_size, (size_t)WS_END);
    }
    Args a{};
    for (int i = 0; i < 28; ++i) a.in[i] = (const float*)d_in[i];
    a.out = (float*)d_out; a.ws = (unsigned char*)d_ws;
    (void)hipMemsetAsync((unsigned char*)d_ws + WS_BAR, 0, 16384, stream);
    void* args[] = {&a};
    hipError_t e = hipLaunchCooperativeKernel((const void*)fwd_megakernel, dim3(grid_blocks), dim3(NTHREADS), args, LDS_BYTES, stream);
    if (e != hipSuccess) fprintf(stderr, "cooperative launch failed: %s (grid %d)\n", hipGetErrorString(e), grid_blocks);
}
```

```cpp
#include <hip/hip_runtime.h>
#include <hip/hip_cooperative_groups.h>
#include <cstdio>
namespace cg = cooperative_groups;

#define LAS __attribute__((address_space(3)))
typedef unsigned short bf16_t;
typedef short bf16x8 __attribute__((ext_vector_type(8)));
typedef float f32x4 __attribute__((ext_vector_type(4)));
typedef unsigned u32x4 __attribute__((ext_vector_type(4)));
typedef unsigned u32x2 __attribute__((ext_vector_type(2)));

constexpr int DM = 1024, BATCH = 16, SEQ = 4096, NB = 2, BG = BATCH / NB, TG = BG * SEQ;
constexpr int NIN = 10240;
constexpr int NMOD = 6 * DM;
constexpr float EPS = 1e-6f;
constexpr int NTHREADS = 512;
constexpr int LDS_BYTES = 131072 + 256;

constexpr size_t MiB = 1024ull * 1024ull;
constexpr size_t WS_WIN = 0;
constexpr size_t WS_WDT = WS_WIN + (size_t)NIN * 1024 * 2;
constexpr size_t WS_WPA = WS_WDT + 32 * 1024 * 2;
constexpr size_t WS_WPB = WS_WPA + 2 * MiB;
constexpr size_t WS_WOUT = WS_WPB + 4 * MiB;
constexpr size_t WS_WFF1 = WS_WOUT + 2 * MiB;
constexpr size_t WS_WFF2 = WS_WFF1 + 8 * MiB;
constexpr size_t WS_WAT = WS_WFF2 + 8 * MiB;
constexpr size_t WS_WXT = WS_WAT + 131072;
constexpr size_t WS_MODP = WS_WXT + 131072;
constexpr size_t WS_MOD = WS_MODP + 16ull * 16 * NMOD * 4;
constexpr size_t WS_CAR = WS_MOD + 16ull * NMOD * 4;
constexpr size_t WS_DT = WS_CAR + (size_t)BG * 64 * 1024 * 8;
constexpr size_t WS_H = WS_DT + (size_t)TG * 32 * 4;
constexpr size_t WS_LX = WS_H + (size_t)TG * 1024 * 2;
constexpr size_t WS_LG = WS_LX + (size_t)TG * 1024 * 2;
constexpr size_t WS_Z = WS_LG + (size_t)TG * 1024 * 2;
constexpr size_t WS_XBC = WS_Z + (size_t)TG * 2048 * 2;
constexpr size_t WS_GT = WS_XBC + (size_t)TG * 4096 * 2;
constexpr size_t WS_YB = WS_GT + (size_t)TG * 2048 * 2;
constexpr size_t WS_CS = WS_YB + (size_t)TG * 2048 * 2;
constexpr size_t WS_BAR = WS_CS + (size_t)TG * 32 * 4;
constexpr size_t WS_END = WS_BAR + 16384;

struct Args { const float* in[28]; float* out; unsigned char* ws; };
typedef const __attribute__((address_space(4))) Args CArgs;

__device__ __forceinline__ bf16_t f2bf(float f) { unsigned u = __float_as_uint(f); u += 0x7FFFu + ((u >> 16) & 1u); return (bf16_t)(u >> 16); }
__device__ __forceinline__ float bf2f(bf16_t b) { return __uint_as_float(((unsigned)b) << 16); }
typedef __bf16 bf16x2_t __attribute__((ext_vector_type(2)));
typedef float f32x2_t __attribute__((ext_vector_type(2)));
__device__ __forceinline__ unsigned pack2(float lo, float hi) { const f32x2_t v = {lo, hi}; return __builtin_bit_cast(unsigned, __builtin_convertvector(v, bf16x2_t)); }
__device__ __forceinline__ float bflo(unsigned w) { return __uint_as_float(w << 16); }
__device__ __forceinline__ float bfhi(unsigned w) { return __uint_as_float(w & 0xffff0000u); }
__device__ __forceinline__ float sigmoidf_(float x) { return __builtin_amdgcn_rcpf(1.0f + __expf(-x)); }
__device__ __forceinline__ float siluf_(float x) { return x * sigmoidf_(x); }
__device__ __forceinline__ float geluf_(float x) { return x * sigmoidf_(1.5957691216f * (x + 0.044715f * x * x * x)); }
__device__ __forceinline__ float softplusf_(float x) { return x > 20.f ? x : log1pf(expf(x)); }
__device__ __forceinline__ float wave_sum(float s, int lane) {
#pragma unroll
    for (int o = 32; o > 0; o >>= 1) s += __int_as_float(__builtin_amdgcn_ds_bpermute((lane ^ o) << 2, __float_as_int(s)));
    return s;
}

__device__ __forceinline__ int otid() { int t = threadIdx.x; asm volatile("" : "+v"(t)); return t; }
__device__ __forceinline__ CArgs* launder(CArgs* p) { asm volatile("" : "+s"(p)); return p; }
__device__ __forceinline__ int obid() { int t = blockIdx.x; asm volatile("" : "+s"(t)); return t; }

#define XB_TMO      128
#define XB_XCNT(j)  (256  + 64 * (j))
#define XB_XSUB(j)  (1280 + 64 * (j))
#define XB_XGEN(j)  (2304 + 64 * (j))
#define XB_TOP      3328
#define XB_TOPGEN   3392
#define XCD_BAR_WORDS 3456
#define XB_SPIN_CAP (1u << 18)
__device__ __forceinline__ unsigned xb_ld(unsigned* p)              { return __hip_atomic_load(p, __ATOMIC_RELAXED, __HIP_MEMORY_SCOPE_AGENT); }
__device__ __forceinline__ unsigned xb_add(unsigned* p, unsigned v) { return __hip_atomic_fetch_add(p, v, __ATOMIC_RELAXED, __HIP_MEMORY_SCOPE_AGENT); }
__device__ __forceinline__ unsigned xb_xcc_id() { return (unsigned)__builtin_amdgcn_s_getreg((3 << 11) | 20) & 0xFu; }
#define XB_SPIN(cond, bar) do { unsigned _sp = 0; while (cond) { __builtin_amdgcn_s_sleep(1); \
    if ((++_sp & 255u) == 0u) { if (xb_ld(&(bar)[XB_TMO])) break; if (_sp > XB_SPIN_CAP) { atomicAdd(&(bar)[XB_TMO], 1u); break; } } } } while (0)
struct XcdBarrier { unsigned* bar; unsigned x; volatile LAS unsigned* st; };
__device__ __forceinline__ XcdBarrier xcd_barrier_post(unsigned* bar, volatile LAS unsigned* st) {
    XcdBarrier b; b.bar = bar; b.x = xb_xcc_id(); b.st = st;
    if (threadIdx.x == 0) (void)xb_add(&bar[XB_XCNT(b.x)], 1u);
    return b;
}
__device__ __forceinline__ void xcd_barrier_complete(unsigned* bar, unsigned x, unsigned& nloc, unsigned& nx) {
    const unsigned G = gridDim.x * gridDim.y * gridDim.z;
    unsigned sum, cnt, mine, sp = 0u;
    for (;;) {
        sum = 0u; cnt = 0u; mine = 0u;
#pragma unroll
        for (unsigned j = 0; j < 16; ++j) { const unsigned c = xb_ld(&bar[XB_XCNT(j)]); sum += c; cnt += (c > 0u) ? 1u : 0u; mine = (j == x) ? c : mine; }
        if (sum == G) break;
        __builtin_amdgcn_s_sleep(1);
        if ((++sp & 255u) == 0u) { if (xb_ld(&bar[XB_TMO])) break; if (sp > XB_SPIN_CAP) { atomicAdd(&bar[XB_TMO], 1u); break; } }
    }
    nloc = mine > 0u ? mine : 1u; nx = cnt > 0u ? cnt : 1u;
}
__device__ __forceinline__ void xcd_barrier(const XcdBarrier& b) {
    asm volatile("s_waitcnt vmcnt(0)" ::: "memory");
    __syncthreads();
    if (threadIdx.x == 0) {
        unsigned* bar = b.bar;
        __builtin_amdgcn_s_waitcnt(0);
        unsigned nloc = b.st[0], nx = b.st[1];
        if (nloc == 0u) { xcd_barrier_complete(bar, b.x, nloc, nx); b.st[0] = nloc; b.st[1] = nx; }
        const unsigned old = xb_add(&bar[XB_XSUB(b.x)], 1u);
        const unsigned gen = old / nloc;
        if (old + 1u == (gen + 1u) * nloc) {
            __builtin_amdgcn_fence(__ATOMIC_RELEASE, "agent");
            asm volatile("s_waitcnt vmcnt(0)" ::: "memory");
            const unsigned og = xb_add(&bar[XB_TOP], 1u);
            const unsigned tg = og / nx;
            if (og + 1u == (tg + 1u) * nx) xb_add(&bar[XB_TOPGEN], 1u);
            else XB_SPIN(xb_ld(&bar[XB_TOPGEN]) == tg, bar);
            __builtin_amdgcn_fence(__ATOMIC_ACQUIRE, "agent");
            asm volatile("s_waitcnt vmcnt(0)" ::: "memory");
        } else {
            XB_SPIN(xb_ld(&bar[XB_TOPGEN]) == gen, bar);
            __builtin_amdgcn_fence(__ATOMIC_ACQUIRE, "agent");
            asm volatile("s_waitcnt vmcnt(0)" ::: "memory");
        }
    }
    __syncthreads();
}

namespace pg8 {
constexpr int BM = 256, BK = 64, HALF = 128, HTB = HALF * BK * 2, STAGE_BYTES = 8 * HTB, NXCD = 8, WGM = 8;
__device__ __forceinline__ int lds_byte(int r, int c) { const int st = (r >> 4) * 2 + (c >> 5), rr = r & 15, cc = c & 31, ob = rr * 64 + cc * 2; return st * 1024 + (ob ^ (((ob >> 9) & 1) << 5)); }
__device__ __forceinline__ void stage_rc(int b, int& R, int& C) { const int st = b / 1024, sb = b % 1024, swz = sb ^ (((sb >> 9) & 1) << 5); R = (st >> 1) * 16 + swz / 64; C = (st & 1) * 32 + (swz % 64) / 2; }
__device__ __forceinline__ int perm32(int rho) { const int n = rho >> 4, i = rho & 15; return 8 * (i >> 2) + 4 * n + (i & 3); }
struct Unit { int pm, pn; };
struct Gemm { const bf16_t* A; const bf16_t* Bt; int M, N, K; };
struct StaticOrder {
    int nM, nN, nwg, G, c, mode;
    __device__ void init(int M, int N, int G_, int c_, int mode_ = 0) { nM = M / BM; nN = N / BM; nwg = nM * nN; G = G_; c = c_; mode = mode_; }
    __device__ bool next(int i, Unit& u) const {
        const long L = (long)i * G + c; if (L >= nwg) return false;
        if (mode == 1 && (G & 7) == 0 && (nN & 7) == 0 && nwg % G == 0) {
            const int x = c & 7, slot = (c >> 3) + (G >> 3) * i, npx = nN >> 3;
            u.pm = slot / npx; u.pn = x * npx + slot % npx; return true; }
        int wgid = (int)L; { const int q = nwg / NXCD, r = nwg % NXCD, xcd = wgid % NXCD, off = wgid / NXCD; wgid = (xcd < r ? xcd * (q + 1) : r * (q + 1) + (xcd - r) * q) + off; }
        const int nig = WGM * nN, gid = wgid / nig, fm = gid * WGM, gsz = (nM - fm) < WGM ? (nM - fm) : WGM;
        u.pm = fm + ((wgid % nig) % gsz); u.pn = (wgid % nig) / gsz; return true;
    }
};

template <class Epi>
__device__ __forceinline__ void gemm_phase(LAS unsigned char* lds, const Gemm g, const StaticOrder& S, const Epi& E) {
    const int tid = otid(), wid = __builtin_amdgcn_readfirstlane(tid >> 6), lane = tid & 63, wr = wid >> 2, wc = wid & 3, fr = lane & 15, fq = lane >> 4;
    const int K = g.K, nt = K / BK;
    unsigned voffA[2], voffB[2];
#pragma unroll
    for (int i = 0; i < 2; ++i) { int R, C; stage_rc(tid * 16 + i * 8192, R, C); const int Rb = ((R & ~31) + perm32(R & 31));
        voffA[i] = (unsigned)(R * K + C) * 2u; voffB[i] = (unsigned)(Rb * K + C) * 2u; }
    const size_t kstep = (size_t)(BK * 2);
    const size_t hstep = (size_t)HALF * K * 2;
    const size_t tstep = 2 * hstep;
    const unsigned ldsw = (unsigned)wid * 1024u;
    const int aoff = lds_byte(wr * 64 + fr, fq * 8), boff = lds_byte(wc * 32 + fr, fq * 8);
#define PG8_SA(b, h) (((b) * 2 + (h)) * HTB)
#define PG8_SB(b, h) ((4 + (b) * 2 + (h)) * HTB)
#define PG8_STAGE(bufoff, gbase, voff) do { _Pragma("unroll") for (int _i = 0; _i < 2; ++_i) \
        __builtin_amdgcn_global_load_lds((const unsigned*)((const char*)(gbase) + (voff)[_i]), (LAS unsigned*)(lds + (bufoff) + ldsw + _i * 8192), 16, 0, 0); } while (0)
#define PG8_LDA(dst, b, h) do { _Pragma("unroll") for (int m = 0; m < 4; ++m) _Pragma("unroll") for (int k = 0; k < 2; ++k) dst[m][k] = *(const LAS bf16x8*)(lds + PG8_SA(b, h) + aoff + m * 2048 + k * 1024); } while (0)
#define PG8_LDB(dst, b, h) do { _Pragma("unroll") for (int n = 0; n < 2; ++n) _Pragma("unroll") for (int k = 0; k < 2; ++k) dst[n][k] = *(const LAS bf16x8*)(lds + PG8_SB(b, h) + boff + n * 2048 + k * 1024); } while (0)
#define PG8_MMA(ai, bj, At, Bt) do { __builtin_amdgcn_s_setprio(1); _Pragma("unroll") for (int m = 0; m < 4; ++m) _Pragma("unroll") for (int n = 0; n < 2; ++n) _Pragma("unroll") for (int k = 0; k < 2; ++k) \
        acc[ai][bj][m][n] = __builtin_amdgcn_mfma_f32_16x16x32_bf16(Bt[n][k], At[m][k], acc[ai][bj][m][n], 0, 0, 0); __builtin_amdgcn_s_setprio(0); } while (0)
#define PG8_WAIT_V(n) asm volatile("s_waitcnt vmcnt(" #n ")" ::: "memory")
#define PG8_WAIT_L(n) asm volatile("s_waitcnt lgkmcnt(" #n ")" ::: "memory")
#define PG8_BAR __builtin_amdgcn_s_barrier()
#define PG8_SCHED __builtin_amdgcn_sched_barrier(0)
    Unit cur, nxt; int ui = 0;
    if (!S.next(0, cur)) return;
    f32x4 acc[2][2][4][2];
#pragma unroll
    for (int a = 0; a < 2; ++a)
#pragma unroll
        for (int b = 0; b < 2; ++b)
#pragma unroll
            for (int m = 0; m < 4; ++m)
#pragma unroll
                for (int n = 0; n < 2; ++n) acc[a][b][m][n] = (f32x4){0.f, 0.f, 0.f, 0.f};
    bf16x8 At[4][2], B0[2][2], B1[2][2];
    const char* cA = (const char*)g.A + (size_t)cur.pm * tstep; const char* cB = (const char*)g.Bt + (size_t)cur.pn * tstep;
    PG8_STAGE(PG8_SB(0, 0), cB, voffB); PG8_STAGE(PG8_SA(0, 0), cA, voffA); PG8_STAGE(PG8_SB(0, 1), cB + hstep, voffB); PG8_STAGE(PG8_SA(0, 1), cA + hstep, voffA);
    if (wr == 1) PG8_BAR;
    PG8_WAIT_V(4); PG8_BAR;
    PG8_STAGE(PG8_SB(1, 0), cB + kstep, voffB); PG8_STAGE(PG8_SA(1, 0), cA + kstep, voffA); PG8_STAGE(PG8_SB(1, 1), cB + hstep + kstep, voffB);
    PG8_WAIT_V(6); PG8_BAR;
    for (;;) {
        const bool has_next = S.next(ui + 1, nxt);
        const char* nA = has_next ? (const char*)g.A + (size_t)nxt.pm * tstep : cA; const char* nB = has_next ? (const char*)g.Bt + (size_t)nxt.pn * tstep : cB;
        for (int t = 0; t < nt; t += 2) {
            const bool last = (t == nt - 2);
            const char* a1 = cA + (size_t)(t + 1) * kstep;
            const char* a2 = last ? nA : cA + (size_t)(t + 2) * kstep; const char* b2 = last ? nB : cB + (size_t)(t + 2) * kstep;
            const char* a3 = a2 + kstep; const char* b3 = b2 + kstep;
            PG8_LDB(B0, 0, 0); PG8_SCHED; PG8_LDA(At, 0, 0); PG8_STAGE(PG8_SA(1, 1), a1 + hstep, voffA);
            PG8_WAIT_L(8); PG8_BAR; PG8_WAIT_L(0); PG8_MMA(0, 0, At, B0); PG8_BAR; PG8_SCHED;
            PG8_LDB(B1, 0, 1); PG8_STAGE(PG8_SB(0, 0), b2, voffB);
            PG8_BAR; PG8_WAIT_L(0); PG8_MMA(0, 1, At, B1); PG8_BAR;
            PG8_LDA(At, 0, 1); PG8_STAGE(PG8_SA(0, 0), a2, voffA);
            PG8_BAR; PG8_WAIT_L(0); PG8_MMA(1, 0, At, B0); PG8_BAR; PG8_SCHED;
            PG8_STAGE(PG8_SB(0, 1), b2 + hstep, voffB);
            PG8_WAIT_V(6); PG8_BAR; PG8_MMA(1, 1, At, B1); PG8_BAR;
            PG8_LDB(B0, 1, 0); PG8_SCHED; PG8_LDA(At, 1, 0); PG8_STAGE(PG8_SA(0, 1), a2 + hstep, voffA);
            PG8_WAIT_L(8); PG8_BAR; PG8_WAIT_L(0); PG8_MMA(0, 0, At, B0); PG8_BAR; PG8_SCHED;
            PG8_LDB(B1, 1, 1); PG8_STAGE(PG8_SB(1, 0), b3, voffB);
            PG8_BAR; PG8_WAIT_L(0); PG8_MMA(0, 1, At, B1); PG8_BAR;
            PG8_LDA(At, 1, 1); PG8_STAGE(PG8_SA(1, 0), a3, voffA);
            PG8_BAR; PG8_WAIT_L(0); PG8_MMA(1, 0, At, B0); PG8_BAR; PG8_SCHED;
            PG8_STAGE(PG8_SB(1, 1), b3 + hstep, voffB);
            PG8_WAIT_V(6); PG8_BAR; PG8_MMA(1, 1, At, B1); PG8_BAR;
        }
        E(acc, cur, wr, wc, fr, fq);
        if (!has_next) break;
#pragma unroll
        for (int a = 0; a < 2; ++a)
#pragma unroll
            for (int b = 0; b < 2; ++b)
#pragma unroll
                for (int m = 0; m < 4; ++m)
#pragma unroll
                    for (int n = 0; n < 2; ++n) acc[a][b][m][n] = (f32x4){0.f, 0.f, 0.f, 0.f};
        cur = nxt; cA = nA; cB = nB; ++ui;
    }
    PG8_WAIT_V(0);
    if (wr == 0) PG8_BAR;
    PG8_BAR;
#undef PG8_SA
#undef PG8_SB
#undef PG8_STAGE
#undef PG8_LDA
#undef PG8_LDB
#undef PG8_MMA
#undef PG8_WAIT_V
#undef PG8_WAIT_L
#undef PG8_BAR
#undef PG8_SCHED
}
}

#define EPI_LOOP_BEGIN \
    const int row0 = u.pm * 256 + wr * 64 + fr, col0 = u.pn * 256 + wc * 32 + 8 * fq; \
    _Pragma("unroll") for (int ai = 0; ai < 2; ++ai) _Pragma("unroll") for (int m = 0; m < 4; ++m) { const int row = row0 + ai * 128 + m * 16; \
    _Pragma("unroll") for (int bj = 0; bj < 2; ++bj) { const int col = col0 + bj * 128; f32x4 v0 = acc[ai][bj][m][0], v1 = acc[ai][bj][m][1];
#define EPI_LOOP_END } }

__device__ __forceinline__ u32x4 pack8(f32x4 v0, f32x4 v1) { u32x4 w; w.x = pack2(v0[0], v0[1]); w.y = pack2(v0[2], v0[3]); w.z = pack2(v1[0], v1[1]); w.w = pack2(v1[2], v1[3]); return w; }

struct EpiIn {
    bf16_t *LX, *LG, *Z, *XBC, *GT;
    __device__ __forceinline__ void operator()(const f32x4 (&acc)[2][2][4][2], const pg8::Unit& u, int wr, int wc, int fr, int fq) const {
        const int pn = u.pn; bf16_t* O; int ld, cb;
        if (pn < 4) { O = LX; ld = 1024; cb = 0; } else if (pn < 8) { O = LG; ld = 1024; cb = 1024; } else if (pn < 16) { O = Z; ld = 2048; cb = 2048; }
        else if (pn < 32) { O = XBC; ld = 4096; cb = 4096; } else { O = GT; ld = 2048; cb = 8192; }
        const bool zact = (pn >= 8 && pn < 16);
        EPI_LOOP_BEGIN
            if (zact) {
#pragma unroll
                for (int j = 0; j < 4; ++j) { v0[j] = siluf_(v0[j]); v1[j] = siluf_(v1[j]); } }
            *(u32x4*)(O + (size_t)row * ld + (col - cb)) = pack8(v0, v1);
        EPI_LOOP_END
    }
};
struct EpiPa {
    bf16_t* TMP; const bf16_t* GT; const float* b_gate;
    __device__ __forceinline__ void operator()(const f32x4 (&acc)[2][2][4][2], const pg8::Unit& u, int wr, int wc, int fr, int fq) const {
        const int row0 = u.pm * 256 + wr * 64 + fr, col0 = u.pn * 256 + wc * 32 + 8 * fq;
        f32x4 bia[2][2];
#pragma unroll
        for (int bj = 0; bj < 2; ++bj) { bia[bj][0] = *(const f32x4*)(b_gate + col0 + bj * 128); bia[bj][1] = *(const f32x4*)(b_gate + col0 + bj * 128 + 4); }
#pragma unroll
        for (int aih = 0; aih < 4; ++aih) { const int ai = aih >> 1, mb = (aih & 1) * 2;
            u32x4 gw[4][2];
#pragma unroll
            for (int m = mb; m < mb + 2; ++m)
#pragma unroll
                for (int bj = 0; bj < 2; ++bj) gw[m][bj] = *(const u32x4*)(GT + (size_t)(row0 + ai * 128 + m * 16) * 2048 + col0 + bj * 128);
#pragma unroll
            for (int m = mb; m < mb + 2; ++m)
#pragma unroll
                for (int bj = 0; bj < 2; ++bj) {
                    f32x4 v0 = acc[ai][bj][m][0], v1 = acc[ai][bj][m][1]; const u32x4 g = gw[m][bj]; const f32x4 b0 = bia[bj][0], b1 = bia[bj][1];
                    v0[0] *= sigmoidf_(bflo(g.x) + b0[0]); v0[1] *= sigmoidf_(bfhi(g.x) + b0[1]); v0[2] *= sigmoidf_(bflo(g.y) + b0[2]); v0[3] *= sigmoidf_(bfhi(g.y) + b0[3]);
                    v1[0] *= sigmoidf_(bflo(g.z) + b1[0]); v1[1] *= sigmoidf_(bfhi(g.z) + b1[1]); v1[2] *= sigmoidf_(bflo(g.w) + b1[2]); v1[3] *= sigmoidf_(bfhi(g.w) + b1[3]);
                    *(u32x4*)(TMP + (size_t)(row0 + ai * 128 + m * 16) * 1024 + col0 + bj * 128) = pack8(v0, v1); }
        }
    }
};
struct EpiPb {
    const bf16_t* TMP; const bf16_t* GT; bf16_t* MG; const float* b_gate;
    __device__ __forceinline__ void operator()(const f32x4 (&acc)[2][2][4][2], const pg8::Unit& u, int wr, int wc, int fr, int fq) const {
        const int row0 = u.pm * 256 + wr * 64 + fr, col0 = u.pn * 256 + wc * 32 + 8 * fq;
        f32x4 bia[2][2];
#pragma unroll
        for (int bj = 0; bj < 2; ++bj) { bia[bj][0] = *(const f32x4*)(b_gate + 1024 + col0 + bj * 128); bia[bj][1] = *(const f32x4*)(b_gate + 1024 + col0 + bj * 128 + 4); }
#pragma unroll
        for (int aih = 0; aih < 4; ++aih) { const int ai = aih >> 1, mb = (aih & 1) * 2;
            u32x4 gw[4][2], tw[4][2];
#pragma unroll
            for (int m = mb; m < mb + 2; ++m)
#pragma unroll
                for (int bj = 0; bj < 2; ++bj) { const size_t r = (size_t)(row0 + ai * 128 + m * 16);
                    gw[m][bj] = *(const u32x4*)(GT + r * 2048 + 1024 + col0 + bj * 128); tw[m][bj] = *(const u32x4*)(TMP + r * 1024 + col0 + bj * 128); }
#pragma unroll
            for (int m = mb; m < mb + 2; ++m)
#pragma unroll
                for (int bj = 0; bj < 2; ++bj) {
                    f32x4 v0 = acc[ai][bj][m][0], v1 = acc[ai][bj][m][1]; const u32x4 g = gw[m][bj], t = tw[m][bj]; const f32x4 b0 = bia[bj][0], b1 = bia[bj][1];
                    v0[0] = bflo(t.x) + v0[0] * sigmoidf_(bflo(g.x) + b0[0]); v0[1] = bfhi(t.x) + v0[1] * sigmoidf_(bfhi(g.x) + b0[1]);
                    v0[2] = bflo(t.y) + v0[2] * sigmoidf_(bflo(g.y) + b0[2]); v0[3] = bfhi(t.y) + v0[3] * sigmoidf_(bfhi(g.y) + b0[3]);
                    v1[0] = bflo(t.z) + v1[0] * sigmoidf_(bflo(g.z) + b1[0]); v1[1] = bfhi(t.z) + v1[1] * sigmoidf_(bfhi(g.z) + b1[1]);
                    v1[2] = bflo(t.w) + v1[2] * sigmoidf_(bflo(g.w) + b1[2]); v1[3] = bfhi(t.w) + v1[3] * sigmoidf_(bfhi(g.w) + b1[3]);
                    *(u32x4*)(MG + (size_t)(row0 + ai * 128 + m * 16) * 1024 + col0 + bj * 128) = pack8(v0, v1); }
        }
    }
};
struct EpiBf {
    bf16_t* C; int ldc;
    __device__ __forceinline__ void operator()(const f32x4 (&acc)[2][2][4][2], const pg8::Unit& u, int wr, int wc, int fr, int fq) const {
        EPI_LOOP_BEGIN
            *(u32x4*)(C + (size_t)row * ldc + col) = pack8(v0, v1);
        EPI_LOOP_END
    }
};
struct EpiF32 {
    float* C; int ldc;
    __device__ __forceinline__ void operator()(const f32x4 (&acc)[2][2][4][2], const pg8::Unit& u, int wr, int wc, int fr, int fq) const {
        EPI_LOOP_BEGIN
            float* o = C + (size_t)row * ldc + col; *(f32x4*)o = v0; *(f32x4*)(o + 4) = v1;
        EPI_LOOP_END
    }
};
struct EpiRelu2 {
    bf16_t* O; int ldc;
    __device__ __forceinline__ void operator()(const f32x4 (&acc)[2][2][4][2], const pg8::Unit& u, int wr, int wc, int fr, int fq) const {
        EPI_LOOP_BEGIN
#pragma unroll
            for (int j = 0; j < 4; ++j) { const float a = fmaxf(v0[j], 0.f), b = fmaxf(v1[j], 0.f); v0[j] = a * a; v1[j] = b * b; }
            *(u32x4*)(O + (size_t)row * ldc + col) = pack8(v0, v1);
        EPI_LOOP_END
    }
};

__device__ void transpose_tile(const float* __restrict__ src, int K, int N, int tile, int job, bf16_t* dst, bf16_t* dst_dt, const float* kscale, float* T) {
    const int tid = otid();
    const int ntn = N / 32, tk = tile / ntn, tn = tile % ntn, k0 = tk * 64, n0 = tn * 32;
    __syncthreads();
#pragma unroll
    for (int i = 0; i < 4; ++i) { const int kk = (tid >> 5) + 16 * i, nn = tid & 31; float v = src[(size_t)(k0 + kk) * N + n0 + nn]; if (kscale) v *= kscale[k0 + kk]; T[kk * 33 + nn] = v; }
    __syncthreads();
    const int n = tid >> 4, kp = (tid & 15) * 4;
    int gn = n0 + n; bf16_t* base = dst;
    if (job == 0) { if (gn >= 8224) gn -= 32; else if (gn >= 8192) { gn -= 8192; base = dst_dt; } }
    u32x2 w; w.x = pack2(T[(kp + 0) * 33 + n], T[(kp + 1) * 33 + n]); w.y = pack2(T[(kp + 2) * 33 + n], T[(kp + 3) * 33 + n]);
    *(u32x2*)(base + (size_t)gn * K + k0 + kp) = w;
}

__device__ void phase_prep(CArgs& a, float* ldsf) {
    unsigned char* ws = a.ws; const int tid = otid(); const int bid = obid();
    const int nt0 = 16 * 321, nt1 = 16 * 32, nt2 = 32 * 32, nt3 = 16 * 32, nt4 = 16 * 128, nt5 = 64 * 32;
    const int tot = nt0 + nt1 + nt2 + nt3 + nt4 + nt5;
    for (int t = bid; t < tot; t += gridDim.x) {
        int r = t;
        if (r < nt0) { transpose_tile(a.in[6], 1024, 10272, r, 0, (bf16_t*)(ws + WS_WIN), (bf16_t*)(ws + WS_WDT), nullptr, ldsf); continue; } r -= nt0;
        if (r < nt1) { transpose_tile(a.in[15], 1024, 1024, r, 1, (bf16_t*)(ws + WS_WPA), nullptr, nullptr, ldsf); continue; } r -= nt1;
        if (r < nt2) { transpose_tile(a.in[22], 2048, 1024, r, 2, (bf16_t*)(ws + WS_WPB), nullptr, a.in[21], ldsf); continue; } r -= nt2;
        if (r < nt3) { transpose_tile(a.in[23], 1024, 1024, r, 3, (bf16_t*)(ws + WS_WOUT), nullptr, nullptr, ldsf); continue; } r -= nt3;
        if (r < nt4) { transpose_tile(a.in[26], 1024, 4096, r, 4, (bf16_t*)(ws + WS_WFF1), nullptr, nullptr, ldsf); continue; } r -= nt4;
        transpose_tile(a.in[27], 4096, 1024, r, 5, (bf16_t*)(ws + WS_WFF2), nullptr, nullptr, ldsf);
    }
    for (int idx = bid * NTHREADS + tid; idx < 2 * 65536; idx += gridDim.x * NTHREADS) {
        const int which = idx >> 16, e = idx & 65535, h = e >> 12, j = (e >> 6) & 63, i = e & 63;
        const float* src = which ? a.in[12] : a.in[10]; bf16_t* dst = (bf16_t*)(ws + (which ? WS_WXT : WS_WAT));
        dst[e] = f2bf(src[h * 4096 + i * 64 + j]);
    }
    __syncthreads();
    if (bid < 192) {
        const int jb = bid % 12, ks = bid / 12;
        float* cs = ldsf;
        for (int i = tid; i < 1024; i += NTHREADS) { const int b = i >> 6, k = i & 63; cs[i] = siluf_(a.in[1][b * 1024 + ks * 64 + k]); }
        __syncthreads();
        const int j = jb * 512 + tid;
        float acc[16];
#pragma unroll
        for (int b = 0; b < 16; ++b) acc[b] = 0.f;
        for (int k = 0; k < 64; ++k) { const float w = a.in[2][(size_t)(ks * 64 + k) * NMOD + j];
#pragma unroll
            for (int b = 0; b < 16; ++b) acc[b] += cs[b * 64 + k] * w; }
        float* mp = (float*)(ws + WS_MODP);
#pragma unroll
        for (int b = 0; b < 16; ++b) mp[((size_t)ks * 16 + b) * NMOD + j] = acc[b];
    }
}
__device__ void phase_mod_reduce(CArgs& a) {
    const float* mp = (const float*)(a.ws + WS_MODP); float* mod = (float*)(a.ws + WS_MOD);
    for (int idx = obid() * NTHREADS + otid(); idx < 16 * NMOD; idx += gridDim.x * NTHREADS) {
        const int j = idx % NMOD; float s = a.in[3][j];
        for (int ks = 0; ks < 16; ++ks) s += mp[(size_t)ks * 16 * NMOD + idx];
        mod[idx] = s;
    }
}

__device__ void phase_h1(CArgs& a, int g) {
    const int tid_ = otid(), lane = tid_ & 63, wv = obid() * 8 + (tid_ >> 6), nwv = gridDim.x * 8;
    const float* mod = (const float*)(a.ws + WS_MOD); bf16_t* H = (bf16_t*)(a.ws + WS_H);
    f32x4 nx[4];
    if (wv < TG) { const f32x4* xr = (const f32x4*)(a.in[0] + (size_t)(g * TG + wv) * 1024);
#pragma unroll
        for (int i = 0; i < 4; ++i) nx[i] = xr[lane + 64 * i]; }
    for (int r = wv; r < TG; r += nwv) {
        const int tok = g * TG + r, b = tok / SEQ;
        f32x4 v[4]; float ss = 0.f;
#pragma unroll
        for (int i = 0; i < 4; ++i) { v[i] = nx[i]; ss += v[i][0] * v[i][0] + v[i][1] * v[i][1] + v[i][2] * v[i][2] + v[i][3] * v[i][3]; }
        if (r + nwv < TG) { const f32x4* xr = (const f32x4*)(a.in[0] + (size_t)(tok + nwv) * 1024);
#pragma unroll
            for (int i = 0; i < 4; ++i) nx[i] = xr[lane + 64 * i]; }
        ss = wave_sum(ss, lane); const float rs = rsqrtf(ss * (1.0f / 1024.0f) + EPS);
#pragma unroll
        for (int i = 0; i < 4; ++i) { const int c = (lane + 64 * i) * 4;
            const f32x4 pw = *(const f32x4*)(a.in[4] + c), sh = *(const f32x4*)(mod + b * NMOD + c), sc = *(const f32x4*)(mod + b * NMOD + 1024 + c);
            f32x4 h;
#pragma unroll
            for (int j = 0; j < 4; ++j) h[j] = v[i][j] * rs * pw[j] * (1.0f + sc[j]) + sh[j];
            u32x2 w; w.x = pack2(h[0], h[1]); w.y = pack2(h[2], h[3]); *(u32x2*)(H + (size_t)r * 1024 + c) = w; }
    }
}

__device__ void phase_dt(CArgs& a) {
    const int tid_ = otid(), lane = tid_ & 63, wv = obid() * 8 + (tid_ >> 6), nwv = gridDim.x * 8, fr = lane & 15, fq = lane >> 4;
    const bf16_t* H = (const bf16_t*)(a.ws + WS_H); const bf16_t* W = (const bf16_t*)(a.ws + WS_WDT); float* DT = (float*)(a.ws + WS_DT);
    for (int tile = wv; tile < TG / 16; tile += nwv) {
        f32x4 c0 = {0.f, 0.f, 0.f, 0.f}, c1 = {0.f, 0.f, 0.f, 0.f};
        const bf16_t* ap = H + (size_t)(tile * 16 + fr) * 1024 + fq * 8; const bf16_t* bp0 = W + (size_t)fr * 1024 + fq * 8; const bf16_t* bp1 = W + (size_t)(16 + fr) * 1024 + fq * 8;
#pragma unroll 8
        for (int ks = 0; ks < 32; ++ks) {
            const bf16x8 av = *(const bf16x8*)(ap + ks * 32), b0 = *(const bf16x8*)(bp0 + ks * 32), b1 = *(const bf16x8*)(bp1 + ks * 32);
            c0 = __builtin_amdgcn_mfma_f32_16x16x32_bf16(av, b0, c0, 0, 0, 0);
            c1 = __builtin_amdgcn_mfma_f32_16x16x32_bf16(av, b1, c1, 0, 0, 0);
        }
        const float bi0 = a.in[18][fr], bi1 = a.in[18][16 + fr];
#pragma unroll
        for (int r = 0; r < 4; ++r) { const int t = tile * 16 + fq * 4 + r; DT[(size_t)t * 32 + fr] = softplusf_(c0[r] + bi0); DT[(size_t)t * 32 + 16 + fr] = softplusf_(c1[r] + bi1); }
    }
}

#define TR_ISSUE(dst, addr) asm volatile("ds_read_b64_tr_b16 %0, %1" : "=&v"(dst) : "v"(addr) : "memory")
__device__ __forceinline__ bf16x8 frag_of(u32x2 lo, u32x2 hi) { u32x4 w; w.x = lo.x; w.y = lo.y; w.z = hi.x; w.w = hi.y; return __builtin_bit_cast(bf16x8, w); }
__device__ __forceinline__ void unpack8(u32x4 w, float* f) { f[0] = bflo(w.x); f[1] = bfhi(w.x); f[2] = bflo(w.y); f[3] = bfhi(w.y); f[4] = bflo(w.z); f[5] = bfhi(w.z); f[6] = bflo(w.w); f[7] = bfhi(w.w); }

__device__ void phase_bcconv(CArgs& a, int g) {
    const int gt = obid() * NTHREADS + otid(), nth = gridDim.x * NTHREADS;
    const bf16_t* XBC = (const bf16_t*)(a.ws + WS_XBC); bf16_t* BCc = (bf16_t*)(a.out + (size_t)g * TG * 1024);
    const float* cw = a.in[16]; const float* cb = a.in[17];
    {
        const int cv = gt & 255, c0 = 2048 + cv * 8;
        float w0[8], w1[8], w2[8], w3[8], bs[8];
#pragma unroll
        for (int j = 0; j < 8; ++j) { w0[j] = cw[c0 + j]; w1[j] = cw[4096 + c0 + j]; w2[j] = cw[8192 + c0 + j]; w3[j] = cw[12288 + c0 + j]; bs[j] = cb[c0 + j]; }
        for (int run = gt >> 8; run < TG / 64; run += nth >> 8) {
            const size_t ts = (size_t)run * 64; const bool first = ((run & 63) == 0);
            float x0[8], x1[8], x2[8], x3[8];
#pragma unroll
            for (int j = 0; j < 8; ++j) { x0[j] = 0.f; x1[j] = 0.f; x2[j] = 0.f; }
            if (!first) { unpack8(*(const u32x4*)(XBC + (ts - 3) * 4096 + c0), x0); unpack8(*(const u32x4*)(XBC + (ts - 2) * 4096 + c0), x1); unpack8(*(const u32x4*)(XBC + (ts - 1) * 4096 + c0), x2); }
            for (int i0 = 0; i0 < 64; i0 += 8) {
                u32x4 raw[8];
#pragma unroll
                for (int i = 0; i < 8; ++i) raw[i] = *(const u32x4*)(XBC + (ts + i0 + i) * 4096 + c0);
#pragma unroll
                for (int i = 0; i < 8; ++i) {
                    unpack8(raw[i], x3);
                    float o[8];
#pragma unroll
                    for (int j = 0; j < 8; ++j) { o[j] = siluf_(bs[j] + w0[j] * x0[j] + w1[j] * x1[j] + w2[j] * x2[j] + w3[j] * x3[j]); x0[j] = x1[j]; x1[j] = x2[j]; x2[j] = x3[j]; }
                    u32x4 w; w.x = pack2(o[0], o[1]); w.y = pack2(o[2], o[3]); w.z = pack2(o[4], o[5]); w.w = pack2(o[6], o[7]);
                    *(u32x4*)(BCc + (ts + i0 + i) * 2048 + cv * 8) = w;
                }
            }
        }
    }
    {
        const float* DT = (const float*)(a.ws + WS_DT); float* CS = (float*)(a.ws + WS_CS);
        for (int idx = gt; idx < BG * 64 * 32; idx += nth) {
            const int hh = idx & 31; const size_t t0 = (size_t)(idx >> 5) * 64; const float Ah = -expf(a.in[19][hh]); float run = 0.f;
            for (int i0 = 0; i0 < 64; i0 += 16) { float d[16];
#pragma unroll
                for (int i = 0; i < 16; ++i) d[i] = DT[(t0 + i0 + i) * 32 + hh];
#pragma unroll
                for (int i = 0; i < 16; ++i) { run += d[i] * Ah; CS[(t0 + i0 + i) * 32 + hh] = run; } }
        }
    }
}

__device__ void phase_ssd(CArgs& a, int g, unsigned char* lds) {
    const int tid0 = otid();
    constexpr int OFF_C = 0, OFF_B = 17408, OFF_S = 34816, OFF_X = 52224, OFF_XW = 61440, OFF_G = 70656, OFF_Y = 79872, OFF_CS = 97280, OFF_DT = 97536;
    const unsigned lb = (unsigned)(size_t)lds;
    float* Ys = (float*)(lds + OFF_Y); float* css = (float*)(lds + OFF_CS); float* dts = (float*)(lds + OFF_DT);
    const bf16_t* XBC = (const bf16_t*)(a.ws + WS_XBC); const bf16_t* Z = (const bf16_t*)(a.ws + WS_Z); bf16_t* YB = (bf16_t*)(a.ws + WS_YB);
    const bf16_t* BCc = (const bf16_t*)(a.out + (size_t)g * TG * 1024);
    const float* DT = (const float*)(a.ws + WS_DT); const float* CS = (const float*)(a.ws + WS_CS); const float* cw = a.in[16]; const float* cb = a.in[17];
    for (int unit0 = obid(); unit0 < BG * 32; unit0 += gridDim.x) {
        const int unit = (gridDim.x == 256) ? ((unit0 & 7) * 32 + (unit0 >> 3)) : unit0;
        const int bl = unit >> 5, h = unit & 31, grp = h >> 2;
        const float Dh = a.in[20][h];
        const int sc0w = h * 64 + (tid0 & 7) * 8;
        float w0[8], w1[8], w2[8], w3[8], bs[8];
#pragma unroll
        for (int j = 0; j < 8; ++j) { const int sc0 = sc0w; w0[j] = cw[sc0 + j]; w1[j] = cw[4096 + sc0 + j]; w2[j] = cw[8192 + sc0 + j]; w3[j] = cw[12288 + sc0 + j]; bs[j] = cb[sc0 + j]; }
        f32x4 accs[4];
#pragma unroll
        for (int i = 0; i < 4; ++i) accs[i] = (f32x4){0.f, 0.f, 0.f, 0.f};
        __syncthreads();
        for (int i = tid0; i < 1088; i += NTHREADS) *(u32x4*)(lds + OFF_S + i * 16) = (u32x4){0u, 0u, 0u, 0u};
        u32x4 px[4], pbc[4], pz; float pdt, pcs, pce;
#define SSD_PREFETCH(B_) do { const int b_ = (B_); const int tidp = otid(), ptok = tidp >> 3, pcv = tidp & 7; const size_t tp0 = (size_t)bl * SEQ + b_ * 64; \
        _Pragma("unroll") for (int k = 0; k < 4; ++k) { const int sp = b_ * 64 + ptok - 3 + k; \
            px[k] = (sp >= 0) ? *(const u32x4*)(XBC + ((size_t)bl * SEQ + sp) * 4096 + h * 64 + pcv * 8) : (u32x4){0u, 0u, 0u, 0u}; } \
        pdt = DT[(tp0 + ptok) * 32 + h]; pcs = CS[(tp0 + ptok) * 32 + h]; pce = CS[(tp0 + 63) * 32 + h]; \
        pz = *(const u32x4*)(Z + (tp0 + ptok) * 2048 + h * 64 + pcv * 8); \
        _Pragma("unroll") for (int i = 0; i < 4; ++i) { const int idx = tidp + 512 * i, which = idx >> 10, rem = idx & 1023, row = rem >> 4, ch = rem & 15; \
            pbc[i] = *(const u32x4*)(BCc + (tp0 + row) * 2048 + which * 1024 + grp * 128 + ch * 8); } } while (0)
        SSD_PREFETCH(0);
        for (int blk = 0; blk < SEQ / 64; ++blk) {
            const size_t t0 = (size_t)bl * SEQ + blk * 64;
            const int tid = otid(), lane = tid & 63, wid = __builtin_amdgcn_readfirstlane(tid >> 6), fr = lane & 15, fq = lane >> 4, tq = (lane & 15) >> 2, tp = lane & 3;
            const int stok = tid >> 3, scv = tid & 7;
            const u32x4 zcur = pz;
            {
                float xr[4][8];
#pragma unroll
                for (int k = 0; k < 4; ++k) unpack8(px[k], xr[k]);
                const float dtv = pdt, csv = pcs, cse = pce, wgt = dtv * __expf(cse - csv);
                float o[8];
#pragma unroll
                for (int j = 0; j < 8; ++j) o[j] = siluf_(bs[j] + w0[j] * xr[0][j] + w1[j] * xr[1][j] + w2[j] * xr[2][j] + w3[j] * xr[3][j]);
                u32x4 w; w.x = pack2(o[0], o[1]); w.y = pack2(o[2], o[3]); w.z = pack2(o[4], o[5]); w.w = pack2(o[6], o[7]);
                *(u32x4*)(lds + OFF_X + stok * 144 + scv * 16) = w;
                w.x = pack2(o[0] * wgt, o[1] * wgt); w.y = pack2(o[2] * wgt, o[3] * wgt); w.z = pack2(o[4] * wgt, o[5] * wgt); w.w = pack2(o[6] * wgt, o[7] * wgt);
                *(u32x4*)(lds + OFF_XW + stok * 144 + scv * 16) = w;
                if (scv == 0) { css[stok] = csv; dts[stok] = dtv; }
#pragma unroll
                for (int i = 0; i < 4; ++i) { const int idx = tid + 512 * i, which = idx >> 10, rem = idx & 1023, row = rem >> 4, ch = rem & 15;
                    *(u32x4*)(lds + (which ? OFF_C : OFF_B) + row * 272 + ch * 16) = pbc[i]; }
            }
            if (blk + 1 < SEQ / 64) SSD_PREFETCH(blk + 1);
            __syncthreads();
            const int li = wid >> 1, si0 = (wid * 2) & 3, si1 = si0 + 1;
            bf16x8 cfr[4], avA[4], avB[4];
#pragma unroll
            for (int ks = 0; ks < 4; ++ks) { cfr[ks] = *(const bf16x8*)(lds + OFF_C + (li * 16 + fr) * 272 + ks * 64 + fq * 16);
                avA[ks] = *(const bf16x8*)(lds + OFF_B + (si0 * 16 + fr) * 272 + ks * 64 + fq * 16); avB[ks] = *(const bf16x8*)(lds + OFF_B + (si1 * 16 + fr) * 272 + ks * 64 + fq * 16); }
            const float csl = css[li * 16 + fr];
            const f32x4 csA = *(const f32x4*)(css + si0 * 16 + fq * 4), dtA = *(const f32x4*)(dts + si0 * 16 + fq * 4), csB = *(const f32x4*)(css + si1 * 16 + fq * 4), dtB = *(const f32x4*)(dts + si1 * 16 + fq * 4);
            {
                u32x2 gwA = {0u, 0u}, gwB = {0u, 0u}; const int l = li * 16 + fr;
                if (si0 <= li) { f32x4 acc = {0.f, 0.f, 0.f, 0.f};
#pragma unroll
                    for (int ks = 0; ks < 4; ++ks) acc = __builtin_amdgcn_mfma_f32_16x16x32_bf16(avA[ks], cfr[ks], acc, 0, 0, 0);
                    float gv[4];
#pragma unroll
                    for (int r = 0; r < 4; ++r) { const int sidx = si0 * 16 + fq * 4 + r; gv[r] = (sidx <= l) ? acc[r] * __expf(csl - csA[r]) * dtA[r] : 0.f; }
                    gwA.x = pack2(gv[0], gv[1]); gwA.y = pack2(gv[2], gv[3]); }
                if (si1 <= li) { f32x4 acc = {0.f, 0.f, 0.f, 0.f};
#pragma unroll
                    for (int ks = 0; ks < 4; ++ks) acc = __builtin_amdgcn_mfma_f32_16x16x32_bf16(avB[ks], cfr[ks], acc, 0, 0, 0);
                    float gv[4];
#pragma unroll
                    for (int r = 0; r < 4; ++r) { const int sidx = si1 * 16 + fq * 4 + r; gv[r] = (sidx <= l) ? acc[r] * __expf(csl - csB[r]) * dtB[r] : 0.f; }
                    gwB.x = pack2(gv[0], gv[1]); gwB.y = pack2(gv[2], gv[3]); }
                *(u32x2*)(lds + OFF_G + (li * 16 + fr) * 144 + (si0 * 16 + fq * 4) * 2) = gwA;
                *(u32x2*)(lds + OFF_G + (li * 16 + fr) * 144 + (si1 * 16 + fq * 4) * 2) = gwB;
            }
            __syncthreads();
            {
                const int pi0 = (wid * 2) & 3;
                const bf16x8 g0 = *(const bf16x8*)(lds + OFF_G + (li * 16 + fr) * 144 + fq * 16), g1 = *(const bf16x8*)(lds + OFF_G + (li * 16 + fr) * 144 + 64 + fq * 16);
                const f32x4 csl4 = *(const f32x4*)(css + li * 16 + fq * 4); const float cs63 = css[63];
                bf16x8 svA[4], svB[4];
#pragma unroll
                for (int ks = 0; ks < 4; ++ks) { svA[ks] = *(const bf16x8*)(lds + OFF_S + (pi0 * 16 + fr) * 272 + ks * 64 + fq * 16); svB[ks] = *(const bf16x8*)(lds + OFF_S + ((pi0 + 1) * 16 + fr) * 272 + ks * 64 + fq * 16); }
                bf16_t xsA[4], xsB[4];
#pragma unroll
                for (int r = 0; r < 4; ++r) { xsA[r] = *(const bf16_t*)(lds + OFF_X + (li * 16 + fq * 4 + r) * 144 + (pi0 * 16 + fr) * 2); xsB[r] = *(const bf16_t*)(lds + OFF_X + (li * 16 + fq * 4 + r) * 144 + ((pi0 + 1) * 16 + fr) * 2); }
                u32x2 xa0, xa1, xa2, xa3, xb0, xb1, xb2, xb3;
                {   const unsigned xa = lb + OFF_X + (8 * fq + tq) * 144 + (pi0 * 16 + 4 * tp) * 2, xb = xa + 32;
                    TR_ISSUE(xa0, xa); TR_ISSUE(xa1, xa + 4 * 144); TR_ISSUE(xa2, xa + 32 * 144); TR_ISSUE(xa3, xa + 36 * 144);
                    TR_ISSUE(xb0, xb); TR_ISSUE(xb1, xb + 4 * 144); TR_ISSUE(xb2, xb + 32 * 144); TR_ISSUE(xb3, xb + 36 * 144); }
                asm volatile("s_waitcnt lgkmcnt(0)" : "+v"(xa0), "+v"(xa1), "+v"(xa2), "+v"(xa3), "+v"(xb0), "+v"(xb1), "+v"(xb2), "+v"(xb3) :: "memory");
                f32x4 adA = {0.f, 0.f, 0.f, 0.f}, aoA = {0.f, 0.f, 0.f, 0.f}, adB = {0.f, 0.f, 0.f, 0.f}, aoB = {0.f, 0.f, 0.f, 0.f};
                adA = __builtin_amdgcn_mfma_f32_16x16x32_bf16(g0, frag_of(xa0, xa1), adA, 0, 0, 0); adB = __builtin_amdgcn_mfma_f32_16x16x32_bf16(g0, frag_of(xb0, xb1), adB, 0, 0, 0);
                if (li >= 2) { adA = __builtin_amdgcn_mfma_f32_16x16x32_bf16(g1, frag_of(xa2, xa3), adA, 0, 0, 0); adB = __builtin_amdgcn_mfma_f32_16x16x32_bf16(g1, frag_of(xb2, xb3), adB, 0, 0, 0); }
#pragma unroll
                for (int ks = 0; ks < 4; ++ks) { aoA = __builtin_amdgcn_mfma_f32_16x16x32_bf16(cfr[ks], svA[ks], aoA, 0, 0, 0); aoB = __builtin_amdgcn_mfma_f32_16x16x32_bf16(cfr[ks], svB[ks], aoB, 0, 0, 0); }
                u32x2 b0, b1, b2, b3, q0, q1, q2, q3, q4, q5, q6, q7, r0, r1, r2, r3, r4, r5, r6, r7;
                {   const unsigned ba = lb + OFF_B + (8 * fq + tq) * 272 + (wid * 16 + 4 * tp) * 2, qa = lb + OFF_XW + (8 * fq + tq) * 144 + (4 * tp) * 2, qb = qa + 32 * 144;
                    TR_ISSUE(b0, ba); TR_ISSUE(b1, ba + 4 * 272); TR_ISSUE(b2, ba + 32 * 272); TR_ISSUE(b3, ba + 36 * 272);
                    TR_ISSUE(q0, qa); TR_ISSUE(q1, qa + 4 * 144); TR_ISSUE(q2, qa + 32); TR_ISSUE(q3, qa + 32 + 4 * 144);
                    TR_ISSUE(q4, qa + 64); TR_ISSUE(q5, qa + 64 + 4 * 144); TR_ISSUE(q6, qa + 96); TR_ISSUE(q7, qa + 96 + 4 * 144);
                    TR_ISSUE(r0, qb); TR_ISSUE(r1, qb + 4 * 144); TR_ISSUE(r2, qb + 32); TR_ISSUE(r3, qb + 32 + 4 * 144);
                    TR_ISSUE(r4, qb + 64); TR_ISSUE(r5, qb + 64 + 4 * 144); TR_ISSUE(r6, qb + 96); TR_ISSUE(r7, qb + 96 + 4 * 144); }
                float yA[4], yB[4];
#pragma unroll
                for (int r = 0; r < 4; ++r) { const float e = __expf(csl4[r]); yA[r] = adA[r] + e * aoA[r] + Dh * bf2f(xsA[r]); yB[r] = adB[r] + e * aoB[r] + Dh * bf2f(xsB[r]); }
                asm volatile("s_waitcnt lgkmcnt(0)" : "+v"(b0), "+v"(b1), "+v"(b2), "+v"(b3), "+v"(q0), "+v"(q1), "+v"(q2), "+v"(q3), "+v"(q4), "+v"(q5), "+v"(q6), "+v"(q7) :: "memory");
                asm volatile("" : "+v"(r0), "+v"(r1), "+v"(r2), "+v"(r3), "+v"(r4), "+v"(r5), "+v"(r6), "+v"(r7) :: "memory");
                const float dec = __expf(cs63);
#pragma unroll
                for (int pt = 0; pt < 4; ++pt) accs[pt] *= dec;
                {   const bf16x8 bf0 = frag_of(b0, b1), bf1 = frag_of(b2, b3);
                    accs[0] = __builtin_amdgcn_mfma_f32_16x16x32_bf16(bf0, frag_of(q0, q1), accs[0], 0, 0, 0);
                    accs[1] = __builtin_amdgcn_mfma_f32_16x16x32_bf16(bf0, frag_of(q2, q3), accs[1], 0, 0, 0);
                    accs[2] = __builtin_amdgcn_mfma_f32_16x16x32_bf16(bf0, frag_of(q4, q5), accs[2], 0, 0, 0);
                    accs[3] = __builtin_amdgcn_mfma_f32_16x16x32_bf16(bf0, frag_of(q6, q7), accs[3], 0, 0, 0);
                    accs[0] = __builtin_amdgcn_mfma_f32_16x16x32_bf16(bf1, frag_of(r0, r1), accs[0], 0, 0, 0);
                    accs[1] = __builtin_amdgcn_mfma_f32_16x16x32_bf16(bf1, frag_of(r2, r3), accs[1], 0, 0, 0);
                    accs[2] = __builtin_amdgcn_mfma_f32_16x16x32_bf16(bf1, frag_of(r4, r5), accs[2], 0, 0, 0);
                    accs[3] = __builtin_amdgcn_mfma_f32_16x16x32_bf16(bf1, frag_of(r6, r7), accs[3], 0, 0, 0); }
#pragma unroll
                for (int r = 0; r < 4; ++r) { const int l = li * 16 + fq * 4 + r; Ys[l * 68 + pi0 * 16 + fr] = yA[r]; Ys[l * 68 + (pi0 + 1) * 16 + fr] = yB[r]; }
            }
            __syncthreads();
#pragma unroll
            for (int pt = 0; pt < 4; ++pt) { u32x2 w; w.x = pack2(accs[pt][0], accs[pt][1]); w.y = pack2(accs[pt][2], accs[pt][3]);
                *(u32x2*)(lds + OFF_S + (pt * 16 + fr) * 272 + (wid * 16 + fq * 4) * 2) = w; }
            {   const f32x4 y0 = *(const f32x4*)(Ys + stok * 68 + scv * 8), y1 = *(const f32x4*)(Ys + stok * 68 + scv * 8 + 4);
                u32x4 w; w.x = pack2(y0[0] * bflo(zcur.x), y0[1] * bfhi(zcur.x)); w.y = pack2(y0[2] * bflo(zcur.y), y0[3] * bfhi(zcur.y));
                w.z = pack2(y1[0] * bflo(zcur.z), y1[1] * bfhi(zcur.z)); w.w = pack2(y1[2] * bflo(zcur.w), y1[3] * bfhi(zcur.w));
                *(u32x4*)(YB + (t0 + stok) * 2048 + h * 64 + scv * 8) = w; }
        }
#undef SSD_PREFETCH
    }
}

__device__ void phase_lru(CArgs& a, unsigned char* lds) {
    const int tid = otid(), lane = tid & 63, wid = __builtin_amdgcn_readfirstlane(tid >> 6), fr = lane & 15, fq = lane >> 4;
    bf16_t* XCb = (bf16_t*)lds;
    float* XCf = (float*)(lds + 9216);
    float* SP = XCf + 64 * 68; float* SH = SP + 512;
    const bf16_t* LX = (const bf16_t*)(a.ws + WS_LX); const bf16_t* LG = (const bf16_t*)(a.ws + WS_LG); bf16_t* YA = (bf16_t*)(a.ws + WS_H);
    const bf16_t* WAT = (const bf16_t*)(a.ws + WS_WAT); const bf16_t* WXT = (const bf16_t*)(a.ws + WS_WXT);
    const float* cw = a.in[8]; const float* cb = a.in[9];
    for (int unit = obid(); unit < BG * 32; unit += gridDim.x) {
        const int bl = unit >> 5, h = (unit >> 1) & 15, jh = unit & 1;
        const int stok = tid >> 3, scv = tid & 7, sc0 = h * 64 + scv * 8;
        float w0[8], w1[8], w2[8], w3[8], bs[8];
#pragma unroll
        for (int j = 0; j < 8; ++j) { w0[j] = cw[sc0 + j]; w1[j] = cw[1024 + sc0 + j]; w2[j] = cw[2048 + sc0 + j]; w3[j] = cw[3072 + sc0 + j]; bs[j] = cb[sc0 + j]; }
        const int tt = wid & 3, nt = wid >> 2, jj = nt * 16 + fr, chg = h * 64 + jh * 32 + jj, seg = tt * 4 + fq;
        const size_t wo = (size_t)h * 4096 + (size_t)(jh * 32 + jj) * 64 + fq * 8;
        const bf16x8 wa0 = *(const bf16x8*)(WAT + wo), wa1 = *(const bf16x8*)(WAT + wo + 32), wx0 = *(const bf16x8*)(WXT + wo), wx1 = *(const bf16x8*)(WXT + wo + 32);
        const float bav = a.in[11][chg], bxv = a.in[13][chg], spv = softplusf_(-a.in[14][chg]);
        float hc = 0.f;
        u32x4 px[4];
#define LRU_PREFETCH(B_) do { const int b_ = (B_); _Pragma("unroll") for (int k = 0; k < 4; ++k) { const int sp = b_ * 64 + stok - 3 + k; \
        px[k] = (sp >= 0) ? *(const u32x4*)(LX + ((size_t)bl * SEQ + sp) * 1024 + sc0) : (u32x4){0u, 0u, 0u, 0u}; } } while (0)
        LRU_PREFETCH(0);
        __syncthreads();
        for (int blk = 0; blk < SEQ / 64; ++blk) {
            const size_t t0 = (size_t)bl * SEQ + blk * 64;
            {
                float xr[4][8];
#pragma unroll
                for (int k = 0; k < 4; ++k) unpack8(px[k], xr[k]);
                float o[8];
#pragma unroll
                for (int j = 0; j < 8; ++j) o[j] = bs[j] + w0[j] * xr[0][j] + w1[j] * xr[1][j] + w2[j] * xr[2][j] + w3[j] * xr[3][j];
                u32x4 w; w.x = pack2(o[0], o[1]); w.y = pack2(o[2], o[3]); w.z = pack2(o[4], o[5]); w.w = pack2(o[6], o[7]);
                *(u32x4*)(XCb + stok * 72 + scv * 8) = w;
                *(f32x4*)(XCf + stok * 68 + scv * 8) = (f32x4){o[0], o[1], o[2], o[3]}; *(f32x4*)(XCf + stok * 68 + scv * 8 + 4) = (f32x4){o[4], o[5], o[6], o[7]};
            }
            bf16_t lgv[4];
#pragma unroll
            for (int r = 0; r < 4; ++r) lgv[r] = LG[(t0 + tt * 16 + fq * 4 + r) * 1024 + chg];
            if (blk + 1 < SEQ / 64) LRU_PREFETCH(blk + 1);
            __syncthreads();
            f32x4 cr = {0.f, 0.f, 0.f, 0.f}, ci = {0.f, 0.f, 0.f, 0.f};
            {   const bf16x8 a0 = *(const bf16x8*)(XCb + (tt * 16 + fr) * 72 + fq * 8), a1 = *(const bf16x8*)(XCb + (tt * 16 + fr) * 72 + 32 + fq * 8);
                cr = __builtin_amdgcn_mfma_f32_16x16x32_bf16(a0, wa0, cr, 0, 0, 0); cr = __builtin_amdgcn_mfma_f32_16x16x32_bf16(a1, wa1, cr, 0, 0, 0);
                ci = __builtin_amdgcn_mfma_f32_16x16x32_bf16(a0, wx0, ci, 0, 0, 0); ci = __builtin_amdgcn_mfma_f32_16x16x32_bf16(a1, wx1, ci, 0, 0, 0); }
            float hl[4], cp[4];
#pragma unroll
            for (int r = 0; r < 4; ++r) { const int tok = tt * 16 + fq * 4 + r;
                const float rr = sigmoidf_(cr[r] + bav), ii = sigmoidf_(ci[r] + bxv);
                const float la = -8.0f * rr * spv, av = __expf(la), uv = __builtin_amdgcn_sqrtf(fmaxf(1.0f - av * av, 0.f)) * ii * XCf[tok * 68 + jh * 32 + jj];
                if (r == 0) { hl[0] = uv; cp[0] = av; } else { hl[r] = av * hl[r - 1] + uv; cp[r] = cp[r - 1] * av; } }
            SP[seg * 32 + jj] = cp[3]; SH[seg * 32 + jj] = hl[3];
            __syncthreads();
            float c = hc, mine = 0.f;
#pragma unroll
            for (int s2 = 0; s2 < 16; ++s2) { if (s2 == seg) mine = c; c = SP[s2 * 32 + jj] * c + SH[s2 * 32 + jj]; }
            hc = c;
#pragma unroll
            for (int r = 0; r < 4; ++r) { const float hv = hl[r] + cp[r] * mine; YA[(t0 + tt * 16 + fq * 4 + r) * 1024 + chg] = f2bf(hv * geluf_(bf2f(lgv[r]))); }
        }
    }
}


__device__ void phase_gnorm(CArgs& a) {
    const int tid_ = otid(), lane = tid_ & 63, wv = obid() * 8 + (tid_ >> 6), nwv = gridDim.x * 8;
    bf16_t* YB = (bf16_t*)(a.ws + WS_YB);
    for (int item = wv; item < TG * 8; item += 16 * nwv) {
        u32x2 w[16];
#pragma unroll
        for (int k = 0; k < 16; ++k) w[k] = (item + k * nwv < TG * 8) ? *(const u32x2*)(YB + (size_t)(item + k * nwv) * 256 + lane * 4) : (u32x2){0u, 0u};
#pragma unroll
        for (int k = 0; k < 16; ++k) {
            const float f0 = bflo(w[k].x), f1 = bfhi(w[k].x), f2 = bflo(w[k].y), f3 = bfhi(w[k].y);
            const float ss = wave_sum(f0 * f0 + f1 * f1 + f2 * f2 + f3 * f3, lane), rs = rsqrtf(ss * (1.0f / 256.0f) + EPS);
            u32x2 o; o.x = pack2(f0 * rs, f1 * rs); o.y = pack2(f2 * rs, f3 * rs); if (item + k * nwv < TG * 8) *(u32x2*)(YB + (size_t)(item + k * nwv) * 256 + lane * 4) = o; }
    }
}

__device__ void phase_mid(CArgs& a, int g) {
    const int tid_ = otid(), lane = tid_ & 63, wv = obid() * 8 + (tid_ >> 6), nwv = gridDim.x * 8;
    const float* mod = (const float*)(a.ws + WS_MOD); bf16_t* H = (bf16_t*)(a.ws + WS_H); const bf16_t* Y1 = (const bf16_t*)(a.ws + WS_XBC + (size_t)TG * 1024 * 4);
    bf16_t* X2 = (bf16_t*)(a.ws + WS_LG);
    u32x2 ny[4]; f32x4 nx[4];
    if (wv < TG) { const u32x2* yr = (const u32x2*)(Y1 + (size_t)wv * 1024); const f32x4* xr = (const f32x4*)(a.in[0] + (size_t)(g * TG + wv) * 1024);
#pragma unroll
        for (int i = 0; i < 4; ++i) { ny[i] = yr[lane + 64 * i]; nx[i] = xr[lane + 64 * i]; } }
    for (int r = wv; r < TG; r += nwv) {
        const int tok = g * TG + r, b = tok / SEQ;
        f32x4 y[4], xv[4]; float ss = 0.f;
#pragma unroll
        for (int i = 0; i < 4; ++i) { const u32x2 yw = ny[i]; xv[i] = nx[i]; y[i] = (f32x4){bflo(yw.x), bfhi(yw.x), bflo(yw.y), bfhi(yw.y)}; ss += y[i][0] * y[i][0] + y[i][1] * y[i][1] + y[i][2] * y[i][2] + y[i][3] * y[i][3]; }
        if (r + nwv < TG) { const u32x2* yr = (const u32x2*)(Y1 + (size_t)(r + nwv) * 1024); const f32x4* xr = (const f32x4*)(a.in[0] + (size_t)(tok + nwv) * 1024);
#pragma unroll
            for (int i = 0; i < 4; ++i) { ny[i] = yr[lane + 64 * i]; nx[i] = xr[lane + 64 * i]; } }
        ss = wave_sum(ss, lane); const float rs = rsqrtf(ss * (1.0f / 1024.0f) + EPS);
        float ss2 = 0.f;
#pragma unroll
        for (int i = 0; i < 4; ++i) { const int c = (lane + 64 * i) * 4; const f32x4 pw = *(const f32x4*)(a.in[5] + c), g1 = *(const f32x4*)(mod + b * NMOD + 2048 + c);
#pragma unroll
            for (int j = 0; j < 4; ++j) { y[i][j] = xv[i][j] + g1[j] * (y[i][j] * rs * pw[j]); ss2 += y[i][j] * y[i][j]; }
            { u32x2 w; w.x = pack2(y[i][0], y[i][1]); w.y = pack2(y[i][2], y[i][3]); *(u32x2*)(X2 + (size_t)r * 1024 + c) = w; } }
        ss2 = wave_sum(ss2, lane); const float rs2 = rsqrtf(ss2 * (1.0f / 1024.0f) + EPS);
#pragma unroll
        for (int i = 0; i < 4; ++i) { const int c = (lane + 64 * i) * 4;
            const f32x4 pw = *(const f32x4*)(a.in[24] + c), sh = *(const f32x4*)(mod + b * NMOD + 3072 + c), sc = *(const f32x4*)(mod + b * NMOD + 4096 + c);
            u32x2 w; w.x = pack2(y[i][0] * rs2 * pw[0] * (1.0f + sc[0]) + sh[0], y[i][1] * rs2 * pw[1] * (1.0f + sc[1]) + sh[1]);
            w.y = pack2(y[i][2] * rs2 * pw[2] * (1.0f + sc[2]) + sh[2], y[i][3] * rs2 * pw[3] * (1.0f + sc[3]) + sh[3]);
            *(u32x2*)(H + (size_t)r * 1024 + c) = w; }
    }
}

__device__ void phase_final(CArgs& a, int g) {
    const int tid_ = otid(), lane = tid_ & 63, wv = obid() * 8 + (tid_ >> 6), nwv = gridDim.x * 8;
    const float* mod = (const float*)(a.ws + WS_MOD); const bf16_t* Y2 = (const bf16_t*)(a.ws + WS_Z); const bf16_t* X2 = (const bf16_t*)(a.ws + WS_LG);
    u32x2 ny[4], nx[4];
    if (wv < TG) { const u32x2* yr = (const u32x2*)(Y2 + (size_t)wv * 1024); const u32x2* xr = (const u32x2*)(X2 + (size_t)wv * 1024);
#pragma unroll
        for (int i = 0; i < 4; ++i) { ny[i] = yr[lane + 64 * i]; nx[i] = xr[lane + 64 * i]; } }
    for (int r = wv; r < TG; r += nwv) {
        const int tok = g * TG + r, b = tok / SEQ;
        f32x4 y[4], xv[4]; float ss = 0.f;
#pragma unroll
        for (int i = 0; i < 4; ++i) { const u32x2 yw = ny[i], xw = nx[i]; xv[i] = (f32x4){bflo(xw.x), bfhi(xw.x), bflo(xw.y), bfhi(xw.y)}; y[i] = (f32x4){bflo(yw.x), bfhi(yw.x), bflo(yw.y), bfhi(yw.y)};
            ss += y[i][0] * y[i][0] + y[i][1] * y[i][1] + y[i][2] * y[i][2] + y[i][3] * y[i][3]; }
        if (r + nwv < TG) { const u32x2* yr = (const u32x2*)(Y2 + (size_t)(r + nwv) * 1024); const u32x2* xr = (const u32x2*)(X2 + (size_t)(r + nwv) * 1024);
#pragma unroll
            for (int i = 0; i < 4; ++i) { ny[i] = yr[lane + 64 * i]; nx[i] = xr[lane + 64 * i]; } }
        ss = wave_sum(ss, lane); const float rs = rsqrtf(ss * (1.0f / 1024.0f) + EPS);
#pragma unroll
        for (int i = 0; i < 4; ++i) { const int c = (lane + 64 * i) * 4; const f32x4 pw = *(const f32x4*)(a.in[25] + c), g2 = *(const f32x4*)(mod + b * NMOD + 5120 + c);
#pragma unroll
            for (int j = 0; j < 4; ++j) xv[i][j] += g2[j] * (y[i][j] * rs * pw[j]);
            *(f32x4*)(a.out + (size_t)tok * 1024 + c) = xv[i]; }
    }
}

__global__ void __launch_bounds__(NTHREADS, 2) fwd_megakernel(Args a_unused) {
    extern __shared__ __attribute__((aligned(16))) unsigned char lds[];
    cg::grid_group grid = cg::this_grid();
    CArgs* ap0 = (CArgs*)__builtin_amdgcn_kernarg_segment_ptr();
#define AA (*launder(ap0))
    const int G = gridDim.x, bid = obid();
    LAS unsigned char* ldsl = (LAS unsigned char*)lds;

    volatile LAS unsigned* xst = (volatile LAS unsigned*)(ldsl + 131072);
    if (threadIdx.x < 4) xst[threadIdx.x] = 0u;
    __syncthreads();
    const XcdBarrier xb = xcd_barrier_post((unsigned*)(AA.ws + WS_BAR), xst);
    phase_prep(AA, (float*)lds);
    {   int never = 0; asm volatile("" : "+s"(never));
        if (never) grid.sync();
        xcd_barrier(xb); }
    phase_mod_reduce(AA);
    xcd_barrier(xb);

    for (int g = 0; g < NB; ++g) {
        phase_h1(AA, g);
        xcd_barrier(xb);
        phase_dt(AA);
        {   pg8::Gemm gm{(const bf16_t*)(AA.ws + WS_H), (const bf16_t*)(AA.ws + WS_WIN), TG, NIN, 1024}; pg8::StaticOrder S; S.init(TG, NIN, G, bid, 1);
            EpiIn E{(bf16_t*)(AA.ws + WS_LX), (bf16_t*)(AA.ws + WS_LG), (bf16_t*)(AA.ws + WS_Z), (bf16_t*)(AA.ws + WS_XBC), (bf16_t*)(AA.ws + WS_GT)};
            pg8::gemm_phase<EpiIn>(ldsl, gm, S, E); }
        xcd_barrier(xb);
        phase_bcconv(AA, g);
        phase_lru(AA, lds);
        xcd_barrier(xb);
        phase_ssd(AA, g, lds);
        xcd_barrier(xb);
        phase_gnorm(AA);
        xcd_barrier(xb);
        {   pg8::StaticOrder S; S.init(TG, 1024, G, bid);
            pg8::Gemm g1{(const bf16_t*)(AA.ws + WS_H), (const bf16_t*)(AA.ws + WS_WPA), TG, 1024, 1024};
            EpiPa E1{(bf16_t*)(AA.ws + WS_XBC), (const bf16_t*)(AA.ws + WS_GT), AA.in[7]};
            pg8::gemm_phase<EpiPa>(ldsl, g1, S, E1);
            pg8::Gemm g2{(const bf16_t*)(AA.ws + WS_YB), (const bf16_t*)(AA.ws + WS_WPB), TG, 1024, 2048};
            EpiPb E2{(const bf16_t*)(AA.ws + WS_XBC), (const bf16_t*)(AA.ws + WS_GT), (bf16_t*)(AA.ws + WS_LX), AA.in[7]};
            pg8::gemm_phase<EpiPb>(ldsl, g2, S, E2); }
        xcd_barrier(xb);
        {   pg8::StaticOrder S; S.init(TG, 1024, G, bid);
            pg8::Gemm g3{(const bf16_t*)(AA.ws + WS_LX), (const bf16_t*)(AA.ws + WS_WOUT), TG, 1024, 1024};
            EpiBf E{(bf16_t*)(AA.ws + WS_XBC + (size_t)TG * 1024 * 4), 1024};
            pg8::gemm_phase<EpiBf>(ldsl, g3, S, E); }
        xcd_barrier(xb);
        phase_mid(AA, g);
        xcd_barrier(xb);
        {   pg8::StaticOrder S; S.init(TG, 4096, G, bid);
            pg8::Gemm g4{(const bf16_t*)(AA.ws + WS_H), (const bf16_t*)(AA.ws + WS_WFF1), TG, 4096, 1024};
            EpiRelu2 E{(bf16_t*)(AA.ws + WS_XBC), 4096};
            pg8::gemm_phase<EpiRelu2>(ldsl, g4, S, E); }
        xcd_barrier(xb);
        {   pg8::StaticOrder S; S.init(TG, 1024, G, bid);
            pg8::Gemm g5{(const bf16_t*)(AA.ws + WS_XBC), (const bf16_t*)(AA.ws + WS_WFF2), TG, 1024, 4096};
            EpiBf E{(bf16_t*)(AA.ws + WS_Z), 1024};
            pg8::gemm_phase<EpiBf>(ldsl, g5, S, E); }
        xcd_barrier(xb);
        phase_final(AA, g);
    }
}

extern "C" void kernel_launch(void* const* d_in, const int* in_sizes, int n_in, void* d_out, int out_size, void* d_ws, size_t ws_size, hipStream_t stream) {
    static int grid_blocks = 0;
    if (!grid_blocks) {
        int dev = 0, cus = 0, per_cu = 0;
        hipGetDevice(&dev);
        hipDeviceGetAttribute(&cus, hipDeviceAttributeMultiprocessorCount, dev);
        hipFuncSetAttribute((const void*)fwd_megakernel, hipFuncAttributeMaxDynamicSharedMemorySize, LDS_BYTES);
        hipOccupancyMaxActiveBlocksPerMultiprocessor(&per_cu, (const void*)fwd_megakernel, NTHREADS, LDS_BYTES);
        if (per_cu < 1) per_cu = 1;
        grid_blocks = cus * per_cu;
        if (ws_size < WS_END) fprintf(stderr, "kernel_launch: workspace too small: %zu < %zu\n", ws_size, (size_t)WS_END);
    }
    Args a{};
    for (int i = 0; i < 28; ++i) a.in[i] = (const float*)d_in[i];
    a.out = (float*)d_out; a.ws = (unsigned char*)d_ws;
    (void)hipMemsetAsync((unsigned char*)d_ws + WS_BAR, 0, 16384, stream);
    void* args[] = {&a};
    hipError_t e = hipLaunchCooperativeKernel((const void*)fwd_megakernel, dim3(grid_blocks), dim3(NTHREADS), args, LDS_BYTES, stream);
    if (e != hipSuccess) fprintf(stderr, "cooperative launch failed: %s (grid %d)\n", hipGetErrorString(e), grid_blocks);
}
```

```cpp
#include <hip/hip_runtime.h>
#include <hip/hip_cooperative_groups.h>
#include <cstdio>
namespace cg = cooperative_groups;

#define LAS __attribute__((address_space(3)))
typedef unsigned short bf16_t;
typedef short bf16x8 __attribute__((ext_vector_type(8)));
typedef float f32x4 __attribute__((ext_vector_type(4)));
typedef unsigned u32x4 __attribute__((ext_vector_type(4)));
typedef unsigned u32x2 __attribute__((ext_vector_type(2)));

constexpr int DM = 1024, BATCH = 16, SEQ = 4096, NB = 2, BG = BATCH / NB, TG = BG * SEQ;
constexpr int NIN = 10240;
constexpr int NMOD = 6 * DM;
constexpr float EPS = 1e-6f;
constexpr int NTHREADS = 512;
constexpr int LDS_BYTES = 131072 + 256;

constexpr size_t MiB = 1024ull * 1024ull;
constexpr size_t WS_WIN = 0;
constexpr size_t WS_WDT = WS_WIN + (size_t)NIN * 1024 * 2;
constexpr size_t WS_WPA = WS_WDT + 32 * 1024 * 2;
constexpr size_t WS_WPB = WS_WPA + 2 * MiB;
constexpr size_t WS_WOUT = WS_WPB + 4 * MiB;
constexpr size_t WS_WFF1 = WS_WOUT + 2 * MiB;
constexpr size_t WS_WFF2 = WS_WFF1 + 8 * MiB;
constexpr size_t WS_WAT = WS_WFF2 + 8 * MiB;
constexpr size_t WS_WXT = WS_WAT + 131072;
constexpr size_t WS_MODP = WS_WXT + 131072;
constexpr size_t WS_MOD = WS_MODP + 16ull * 16 * NMOD * 4;
constexpr size_t WS_CAR = WS_MOD + 16ull * NMOD * 4;
constexpr size_t WS_DT = WS_CAR + (size_t)BG * 64 * 1024 * 8;
constexpr size_t WS_H = WS_DT + (size_t)TG * 32 * 4;
constexpr size_t WS_LX = WS_H + (size_t)TG * 1024 * 2;
constexpr size_t WS_LG = WS_LX + (size_t)TG * 1024 * 2;
constexpr size_t WS_Z = WS_LG + (size_t)TG * 1024 * 2;
constexpr size_t WS_XBC = WS_Z + (size_t)TG * 2048 * 2;
constexpr size_t WS_GT = WS_XBC + (size_t)TG * 4096 * 2;
constexpr size_t WS_YB = WS_GT + (size_t)TG * 2048 * 2;
constexpr size_t WS_CS = WS_YB + (size_t)TG * 2048 * 2;
constexpr size_t WS_BAR = WS_CS + (size_t)TG * 32 * 4;
constexpr size_t WS_END = WS_BAR + 16384;

struct Args { const float* in[28]; float* out; unsigned char* ws; };
typedef const __attribute__((address_space(4))) Args CArgs;

__device__ __forceinline__ bf16_t f2bf(float f) { unsigned u = __float_as_uint(f); u += 0x7FFFu + ((u >> 16) & 1u); return (bf16_t)(u >> 16); }
__device__ __forceinline__ float bf2f(bf16_t b) { return __uint_as_float(((unsigned)b) << 16); }
typedef __bf16 bf16x2_t __attribute__((ext_vector_type(2)));
typedef float f32x2_t __attribute__((ext_vector_type(2)));
__device__ __forceinline__ unsigned pack2(float lo, float hi) { const f32x2_t v = {lo, hi}; return __builtin_bit_cast(unsigned, __builtin_convertvector(v, bf16x2_t)); }
__device__ __forceinline__ float bflo(unsigned w) { return __uint_as_float(w << 16); }
__device__ __forceinline__ float bfhi(unsigned w) { return __uint_as_float(w & 0xffff0000u); }
__device__ __forceinline__ float sigmoidf_(float x) { return __builtin_amdgcn_rcpf(1.0f + __expf(-x)); }
__device__ __forceinline__ float siluf_(float x) { return x * sigmoidf_(x); }
__device__ __forceinline__ float geluf_(float x) { return x * sigmoidf_(1.5957691216f * (x + 0.044715f * x * x * x)); }
__device__ __forceinline__ float softplusf_(float x) { return x > 20.f ? x : log1pf(expf(x)); }
__device__ __forceinline__ float wave_sum(float s, int lane) {
#pragma unroll
    for (int o = 32; o > 0; o >>= 1) s += __int_as_float(__builtin_amdgcn_ds_bpermute((lane ^ o) << 2, __float_as_int(s)));
    return s;
}

__device__ __forceinline__ int otid() { int t = threadIdx.x; asm volatile("" : "+v"(t)); return t; }
__device__ __forceinline__ CArgs* launder(CArgs* p) { asm volatile("" : "+s"(p)); return p; }
__device__ __forceinline__ int obid() { int t = blockIdx.x; asm volatile("" : "+s"(t)); return t; }

#define XB_TMO      128
#define XB_XCNT(j)  (256  + 64 * (j))
#define XB_XSUB(j)  (1280 + 64 * (j))
#define XB_XGEN(j)  (2304 + 64 * (j))
#define XB_TOP      3328
#define XB_TOPGEN   3392
#define XCD_BAR_WORDS 3456
#define XB_SPIN_CAP (1u << 18)
__device__ __forceinline__ unsigned xb_ld(unsigned* p)              { return __hip_atomic_load(p, __ATOMIC_RELAXED, __HIP_MEMORY_SCOPE_AGENT); }
__device__ __forceinline__ unsigned xb_add(unsigned* p, unsigned v) { return __hip_atomic_fetch_add(p, v, __ATOMIC_RELAXED, __HIP_MEMORY_SCOPE_AGENT); }
__device__ __forceinline__ unsigned xb_xcc_id() { return (unsigned)__builtin_amdgcn_s_getreg((3 << 11) | 20) & 0xFu; }
#define XB_SPIN(cond, bar) do { unsigned _sp = 0; while (cond) { __builtin_amdgcn_s_sleep(1); \
    if ((++_sp & 255u) == 0u) { if (xb_ld(&(bar)[XB_TMO])) break; if (_sp > XB_SPIN_CAP) { atomicAdd(&(bar)[XB_TMO], 1u); break; } } } } while (0)
struct XcdBarrier { unsigned* bar; unsigned x; volatile LAS unsigned* st; };
__device__ __forceinline__ XcdBarrier xcd_barrier_post(unsigned* bar, volatile LAS unsigned* st) {
    XcdBarrier b; b.bar = bar; b.x = xb_xcc_id(); b.st = st;
    if (threadIdx.x == 0) (void)xb_add(&bar[XB_XCNT(b.x)], 1u);
    return b;
}
__device__ __forceinline__ void xcd_barrier_complete(unsigned* bar, unsigned x, unsigned& nloc, unsigned& nx) {
    const unsigned G = gridDim.x * gridDim.y * gridDim.z;
    unsigned sum, cnt, mine, sp = 0u;
    for (;;) {
        sum = 0u; cnt = 0u; mine = 0u;
#pragma unroll
        for (unsigned j = 0; j < 16; ++j) { const unsigned c = xb_ld(&bar[XB_XCNT(j)]); sum += c; cnt += (c > 0u) ? 1u : 0u; mine = (j == x) ? c : mine; }
        if (sum == G) break;
        __builtin_amdgcn_s_sleep(1);
        if ((++sp & 255u) == 0u) { if (xb_ld(&bar[XB_TMO])) break; if (sp > XB_SPIN_CAP) { atomicAdd(&bar[XB_TMO], 1u); break; } }
    }
    nloc = mine > 0u ? mine : 1u; nx = cnt > 0u ? cnt : 1u;
}
__device__ __forceinline__ void xcd_barrier(const XcdBarrier& b) {
    asm volatile("s_waitcnt vmcnt(0)" ::: "memory");
    __syncthreads();
    if (threadIdx.x == 0) {
        unsigned* bar = b.bar;
        __builtin_amdgcn_s_waitcnt(0);
        unsigned nloc = b.st[0], nx = b.st[1];
        if (nloc == 0u) { xcd_barrier_complete(bar, b.x, nloc, nx); b.st[0] = nloc; b.st[1] = nx; }
        const unsigned old = xb_add(&bar[XB_XSUB(b.x)], 1u);
        const unsigned gen = old / nloc;
        if (old + 1u == (gen + 1u) * nloc) {
            __builtin_amdgcn_fence(__ATOMIC_RELEASE, "agent");
            asm volatile("s_waitcnt vmcnt(0)" ::: "memory");
            (void)xb_add(&bar[XB_TOP], 1u);
        }
        XB_SPIN(xb_ld(&bar[XB_TOP]) < (gen + 1u) * nx, bar);
        __builtin_amdgcn_fence(__ATOMIC_ACQUIRE, "agent");
        asm volatile("s_waitcnt vmcnt(0)" ::: "memory");
    }
    __syncthreads();
}

namespace pg8 {
constexpr int BM = 256, BK = 64, HALF = 128, HTB = HALF * BK * 2, STAGE_BYTES = 8 * HTB, NXCD = 8, WGM = 8;
__device__ __forceinline__ int lds_byte(int r, int c) { const int st = (r >> 4) * 2 + (c >> 5), rr = r & 15, cc = c & 31, ob = rr * 64 + cc * 2; return st * 1024 + (ob ^ (((ob >> 9) & 1) << 5)); }
__device__ __forceinline__ void stage_rc(int b, int& R, int& C) { const int st = b / 1024, sb = b % 1024, swz = sb ^ (((sb >> 9) & 1) << 5); R = (st >> 1) * 16 + swz / 64; C = (st & 1) * 32 + (swz % 64) / 2; }
__device__ __forceinline__ int perm32(int rho) { const int n = rho >> 4, i = rho & 15; return 8 * (i >> 2) + 4 * n + (i & 3); }
struct Unit { int pm, pn; };
struct Gemm { const bf16_t* A; const bf16_t* Bt; int M, N, K; };
struct StaticOrder {
    int nM, nN, nwg, G, c, mode;
    __device__ void init(int M, int N, int G_, int c_, int mode_ = 0) { nM = M / BM; nN = N / BM; nwg = nM * nN; G = G_; c = c_; mode = mode_; }
    __device__ bool next(int i, Unit& u) const {
        const long L = (long)i * G + c; if (L >= nwg) return false;
        if (mode == 1 && (G & 7) == 0 && (nN & 7) == 0 && nwg % G == 0) {
            const int x = c & 7, slot = (c >> 3) + (G >> 3) * i, npx = nN >> 3;
            u.pm = slot / npx; u.pn = x * npx + slot % npx; return true; }
        int wgid = (int)L; { const int q = nwg / NXCD, r = nwg % NXCD, xcd = wgid % NXCD, off = wgid / NXCD; wgid = (xcd < r ? xcd * (q + 1) : r * (q + 1) + (xcd - r) * q) + off; }
        const int nig = WGM * nN, gid = wgid / nig, fm = gid * WGM, gsz = (nM - fm) < WGM ? (nM - fm) : WGM;
        u.pm = fm + ((wgid % nig) % gsz); u.pn = (wgid % nig) / gsz; return true;
    }
};

template <class Epi>
__device__ __forceinline__ void gemm_phase(LAS unsigned char* lds, const Gemm g, const StaticOrder& S, const Epi& E) {
    const int tid = otid(), wid = __builtin_amdgcn_readfirstlane(tid >> 6), lane = tid & 63, wr = wid >> 2, wc = wid & 3, fr = lane & 15, fq = lane >> 4;
    const int K = g.K, nt = K / BK;
    unsigned voffA[2], voffB[2];
#pragma unroll
    for (int i = 0; i < 2; ++i) { int R, C; stage_rc(tid * 16 + i * 8192, R, C); const int Rb = ((R & ~31) + perm32(R & 31));
        voffA[i] = (unsigned)(R * K + C) * 2u; voffB[i] = (unsigned)(Rb * K + C) * 2u; }
    const size_t kstep = (size_t)(BK * 2);
    const size_t hstep = (size_t)HALF * K * 2;
    const size_t tstep = 2 * hstep;
    const unsigned ldsw = (unsigned)wid * 1024u;
    const int aoff = lds_byte(wr * 64 + fr, fq * 8), boff = lds_byte(wc * 32 + fr, fq * 8);
#define PG8_SA(b, h) (((b) * 2 + (h)) * HTB)
#define PG8_SB(b, h) ((4 + (b) * 2 + (h)) * HTB)
#define PG8_STAGE(bufoff, gbase, voff) do { _Pragma("unroll") for (int _i = 0; _i < 2; ++_i) \
        __builtin_amdgcn_global_load_lds((const unsigned*)((const char*)(gbase) + (voff)[_i]), (LAS unsigned*)(lds + (bufoff) + ldsw + _i * 8192), 16, 0, 0); } while (0)
#define PG8_LDA(dst, b, h) do { _Pragma("unroll") for (int m = 0; m < 4; ++m) _Pragma("unroll") for (int k = 0; k < 2; ++k) dst[m][k] = *(const LAS bf16x8*)(lds + PG8_SA(b, h) + aoff + m * 2048 + k * 1024); } while (0)
#define PG8_LDB(dst, b, h) do { _Pragma("unroll") for (int n = 0; n < 2; ++n) _Pragma("unroll") for (int k = 0; k < 2; ++k) dst[n][k] = *(const LAS bf16x8*)(lds + PG8_SB(b, h) + boff + n * 2048 + k * 1024); } while (0)
#define PG8_MMA(ai, bj, At, Bt) do { __builtin_amdgcn_s_setprio(1); _Pragma("unroll") for (int m = 0; m < 4; ++m) _Pragma("unroll") for (int n = 0; n < 2; ++n) _Pragma("unroll") for (int k = 0; k < 2; ++k) \
        acc[ai][bj][m][n] = __builtin_amdgcn_mfma_f32_16x16x32_bf16(Bt[n][k], At[m][k], acc[ai][bj][m][n], 0, 0, 0); __builtin_amdgcn_s_setprio(0); } while (0)
#define PG8_WAIT_V(n) asm volatile("s_waitcnt vmcnt(" #n ")" ::: "memory")
#define PG8_WAIT_L(n) asm volatile("s_waitcnt lgkmcnt(" #n ")" ::: "memory")
#define PG8_BAR __builtin_amdgcn_s_barrier()
#define PG8_SCHED __builtin_amdgcn_sched_barrier(0)
    Unit cur, nxt; int ui = 0;
    if (!S.next(0, cur)) return;
    f32x4 acc[2][2][4][2];
#pragma unroll
    for (int a = 0; a < 2; ++a)
#pragma unroll
        for (int b = 0; b < 2; ++b)
#pragma unroll
            for (int m = 0; m < 4; ++m)
#pragma unroll
                for (int n = 0; n < 2; ++n) acc[a][b][m][n] = (f32x4){0.f, 0.f, 0.f, 0.f};
    bf16x8 At[4][2], B0[2][2], B1[2][2];
    const char* cA = (const char*)g.A + (size_t)cur.pm * tstep; const char* cB = (const char*)g.Bt + (size_t)cur.pn * tstep;
    PG8_STAGE(PG8_SB(0, 0), cB, voffB); PG8_STAGE(PG8_SA(0, 0), cA, voffA); PG8_STAGE(PG8_SB(0, 1), cB + hstep, voffB); PG8_STAGE(PG8_SA(0, 1), cA + hstep, voffA);
    if (wr == 1) PG8_BAR;
    PG8_WAIT_V(4); PG8_BAR;
    PG8_STAGE(PG8_SB(1, 0), cB + kstep, voffB); PG8_STAGE(PG8_SA(1, 0), cA + kstep, voffA); PG8_STAGE(PG8_SB(1, 1), cB + hstep + kstep, voffB);
    PG8_WAIT_V(6); PG8_BAR;
    for (;;) {
        const bool has_next = S.next(ui + 1, nxt);
        const char* nA = has_next ? (const char*)g.A + (size_t)nxt.pm * tstep : cA; const char* nB = has_next ? (const char*)g.Bt + (size_t)nxt.pn * tstep : cB;
        for (int t = 0; t < nt; t += 2) {
            const bool last = (t == nt - 2);
            const char* a1 = cA + (size_t)(t + 1) * kstep;
            const char* a2 = last ? nA : cA + (size_t)(t + 2) * kstep; const char* b2 = last ? nB : cB + (size_t)(t + 2) * kstep;
            const char* a3 = a2 + kstep; const char* b3 = b2 + kstep;
            PG8_LDB(B0, 0, 0); PG8_SCHED; PG8_LDA(At, 0, 0); PG8_STAGE(PG8_SA(1, 1), a1 + hstep, voffA);
            PG8_WAIT_L(8); PG8_BAR; PG8_WAIT_L(0); PG8_MMA(0, 0, At, B0); PG8_BAR; PG8_SCHED;
            PG8_LDB(B1, 0, 1); PG8_STAGE(PG8_SB(0, 0), b2, voffB);
            PG8_BAR; PG8_WAIT_L(0); PG8_MMA(0, 1, At, B1); PG8_BAR;
            PG8_LDA(At, 0, 1); PG8_STAGE(PG8_SA(0, 0), a2, voffA);
            PG8_BAR; PG8_WAIT_L(0); PG8_MMA(1, 0, At, B0); PG8_BAR; PG8_SCHED;
            PG8_STAGE(PG8_SB(0, 1), b2 + hstep, voffB);
            PG8_WAIT_V(6); PG8_BAR; PG8_MMA(1, 1, At, B1); PG8_BAR;
            PG8_LDB(B0, 1, 0); PG8_SCHED; PG8_LDA(At, 1, 0); PG8_STAGE(PG8_SA(0, 1), a2 + hstep, voffA);
            PG8_WAIT_L(8); PG8_BAR; PG8_WAIT_L(0); PG8_MMA(0, 0, At, B0); PG8_BAR; PG8_SCHED;
            PG8_LDB(B1, 1, 1); PG8_STAGE(PG8_SB(1, 0), b3, voffB);
            PG8_BAR; PG8_WAIT_L(0); PG8_MMA(0, 1, At, B1); PG8_BAR;
            PG8_LDA(At, 1, 1); PG8_STAGE(PG8_SA(1, 0), a3, voffA);
            PG8_BAR; PG8_WAIT_L(0); PG8_MMA(1, 0, At, B0); PG8_BAR; PG8_SCHED;
            PG8_STAGE(PG8_SB(1, 1), b3 + hstep, voffB);
            PG8_WAIT_V(6); PG8_BAR; PG8_MMA(1, 1, At, B1); PG8_BAR;
        }
        E(acc, cur, wr, wc, fr, fq);
        if (!has_next) break;
#pragma unroll
        for (int a = 0; a < 2; ++a)
#pragma unroll
            for (int b = 0; b < 2; ++b)
#pragma unroll
                for (int m = 0; m < 4; ++m)
#pragma unroll
                    for (int n = 0; n < 2; ++n) acc[a][b][m][n] = (f32x4){0.f, 0.f, 0.f, 0.f};
        cur = nxt; cA = nA; cB = nB; ++ui;
    }
    PG8_WAIT_V(0);
    if (wr == 0) PG8_BAR;
    PG8_BAR;
#undef PG8_SA
#undef PG8_SB
#undef PG8_STAGE
#undef PG8_LDA
#undef PG8_LDB
#undef PG8_MMA
#undef PG8_WAIT_V
#undef PG8_WAIT_L
#undef PG8_BAR
#undef PG8_SCHED
}
}

#define EPI_LOOP_BEGIN \
    const int row0 = u.pm * 256 + wr * 64 + fr, col0 = u.pn * 256 + wc * 32 + 8 * fq; \
    _Pragma("unroll") for (int ai = 0; ai < 2; ++ai) _Pragma("unroll") for (int m = 0; m < 4; ++m) { const int row = row0 + ai * 128 + m * 16; \
    _Pragma("unroll") for (int bj = 0; bj < 2; ++bj) { const int col = col0 + bj * 128; f32x4 v0 = acc[ai][bj][m][0], v1 = acc[ai][bj][m][1];
#define EPI_LOOP_END } }

__device__ __forceinline__ u32x4 pack8(f32x4 v0, f32x4 v1) { u32x4 w; w.x = pack2(v0[0], v0[1]); w.y = pack2(v0[2], v0[3]); w.z = pack2(v1[0], v1[1]); w.w = pack2(v1[2], v1[3]); return w; }

struct EpiIn {
    bf16_t *LX, *LG, *Z, *XBC, *GT;
    __device__ __forceinline__ void operator()(const f32x4 (&acc)[2][2][4][2], const pg8::Unit& u, int wr, int wc, int fr, int fq) const {
        const int pn = u.pn; bf16_t* O; int ld, cb;
        if (pn < 4) { O = LX; ld = 1024; cb = 0; } else if (pn < 8) { O = LG; ld = 1024; cb = 1024; } else if (pn < 16) { O = Z; ld = 2048; cb = 2048; }
        else if (pn < 32) { O = XBC; ld = 4096; cb = 4096; } else { O = GT; ld = 2048; cb = 8192; }
        const bool zact = (pn >= 8 && pn < 16);
        EPI_LOOP_BEGIN
            if (zact) {
#pragma unroll
                for (int j = 0; j < 4; ++j) { v0[j] = siluf_(v0[j]); v1[j] = siluf_(v1[j]); } }
            *(u32x4*)(O + (size_t)row * ld + (col - cb)) = pack8(v0, v1);
        EPI_LOOP_END
    }
};
struct EpiPa {
    bf16_t* TMP; const bf16_t* GT; const float* b_gate;
    __device__ __forceinline__ void operator()(const f32x4 (&acc)[2][2][4][2], const pg8::Unit& u, int wr, int wc, int fr, int fq) const {
        const int row0 = u.pm * 256 + wr * 64 + fr, col0 = u.pn * 256 + wc * 32 + 8 * fq;
        f32x4 bia[2][2];
#pragma unroll
        for (int bj = 0; bj < 2; ++bj) { bia[bj][0] = *(const f32x4*)(b_gate + col0 + bj * 128); bia[bj][1] = *(const f32x4*)(b_gate + col0 + bj * 128 + 4); }
#pragma unroll
        for (int aih = 0; aih < 4; ++aih) { const int ai = aih >> 1, mb = (aih & 1) * 2;
            u32x4 gw[4][2];
#pragma unroll
            for (int m = mb; m < mb + 2; ++m)
#pragma unroll
                for (int bj = 0; bj < 2; ++bj) gw[m][bj] = *(const u32x4*)(GT + (size_t)(row0 + ai * 128 + m * 16) * 2048 + col0 + bj * 128);
#pragma unroll
            for (int m = mb; m < mb + 2; ++m)
#pragma unroll
                for (int bj = 0; bj < 2; ++bj) {
                    f32x4 v0 = acc[ai][bj][m][0], v1 = acc[ai][bj][m][1]; const u32x4 g = gw[m][bj]; const f32x4 b0 = bia[bj][0], b1 = bia[bj][1];
                    v0[0] *= sigmoidf_(bflo(g.x) + b0[0]); v0[1] *= sigmoidf_(bfhi(g.x) + b0[1]); v0[2] *= sigmoidf_(bflo(g.y) + b0[2]); v0[3] *= sigmoidf_(bfhi(g.y) + b0[3]);
                    v1[0] *= sigmoidf_(bflo(g.z) + b1[0]); v1[1] *= sigmoidf_(bfhi(g.z) + b1[1]); v1[2] *= sigmoidf_(bflo(g.w) + b1[2]); v1[3] *= sigmoidf_(bfhi(g.w) + b1[3]);
                    *(u32x4*)(TMP + (size_t)(row0 + ai * 128 + m * 16) * 1024 + col0 + bj * 128) = pack8(v0, v1); }
        }
    }
};
struct EpiPb {
    const bf16_t* TMP; const bf16_t* GT; bf16_t* MG; const float* b_gate;
    __device__ __forceinline__ void operator()(const f32x4 (&acc)[2][2][4][2], const pg8::Unit& u, int wr, int wc, int fr, int fq) const {
        const int row0 = u.pm * 256 + wr * 64 + fr, col0 = u.pn * 256 + wc * 32 + 8 * fq;
        f32x4 bia[2][2];
#pragma unroll
        for (int bj = 0; bj < 2; ++bj) { bia[bj][0] = *(const f32x4*)(b_gate + 1024 + col0 + bj * 128); bia[bj][1] = *(const f32x4*)(b_gate + 1024 + col0 + bj * 128 + 4); }
#pragma unroll
        for (int aih = 0; aih < 4; ++aih) { const int ai = aih >> 1, mb = (aih & 1) * 2;
            u32x4 gw[4][2], tw[4][2];
#pragma unroll
            for (int m = mb; m < mb + 2; ++m)
#pragma unroll
                for (int bj = 0; bj < 2; ++bj) { const size_t r = (size_t)(row0 + ai * 128 + m * 16);
                    gw[m][bj] = *(const u32x4*)(GT + r * 2048 + 1024 + col0 + bj * 128); tw[m][bj] = *(const u32x4*)(TMP + r * 1024 + col0 + bj * 128); }
#pragma unroll
            for (int m = mb; m < mb + 2; ++m)
#pragma unroll
                for (int bj = 0; bj < 2; ++bj) {
                    f32x4 v0 = acc[ai][bj][m][0], v1 = acc[ai][bj][m][1]; const u32x4 g = gw[m][bj], t = tw[m][bj]; const f32x4 b0 = bia[bj][0], b1 = bia[bj][1];
                    v0[0] = bflo(t.x) + v0[0] * sigmoidf_(bflo(g.x) + b0[0]); v0[1] = bfhi(t.x) + v0[1] * sigmoidf_(bfhi(g.x) + b0[1]);
                    v0[2] = bflo(t.y) + v0[2] * sigmoidf_(bflo(g.y) + b0[2]); v0[3] = bfhi(t.y) + v0[3] * sigmoidf_(bfhi(g.y) + b0[3]);
                    v1[0] = bflo(t.z) + v1[0] * sigmoidf_(bflo(g.z) + b1[0]); v1[1] = bfhi(t.z) + v1[1] * sigmoidf_(bfhi(g.z) + b1[1]);
                    v1[2] = bflo(t.w) + v1[2] * sigmoidf_(bflo(g.w) + b1[2]); v1[3] = bfhi(t.w) + v1[3] * sigmoidf_(bfhi(g.w) + b1[3]);
                    *(u32x4*)(MG + (size_t)(row0 + ai * 128 + m * 16) * 1024 + col0 + bj * 128) = pack8(v0, v1); }
        }
    }
};
struct EpiBf {
    bf16_t* C; int ldc;
    __device__ __forceinline__ void operator()(const f32x4 (&acc)[2][2][4][2], const pg8::Unit& u, int wr, int wc, int fr, int fq) const {
        EPI_LOOP_BEGIN
            *(u32x4*)(C + (size_t)row * ldc + col) = pack8(v0, v1);
        EPI_LOOP_END
    }
};
struct EpiF32 {
    float* C; int ldc;
    __device__ __forceinline__ void operator()(const f32x4 (&acc)[2][2][4][2], const pg8::Unit& u, int wr, int wc, int fr, int fq) const {
        EPI_LOOP_BEGIN
            float* o = C + (size_t)row * ldc + col; *(f32x4*)o = v0; *(f32x4*)(o + 4) = v1;
        EPI_LOOP_END
    }
};
struct EpiRelu2 {
    bf16_t* O; int ldc;
    __device__ __forceinline__ void operator()(const f32x4 (&acc)[2][2][4][2], const pg8::Unit& u, int wr, int wc, int fr, int fq) const {
        EPI_LOOP_BEGIN
#pragma unroll
            for (int j = 0; j < 4; ++j) { const float a = fmaxf(v0[j], 0.f), b = fmaxf(v1[j], 0.f); v0[j] = a * a; v1[j] = b * b; }
            *(u32x4*)(O + (size_t)row * ldc + col) = pack8(v0, v1);
        EPI_LOOP_END
    }
};

__device__ void transpose_tile(const float* __restrict__ src, int K, int N, int tile, int job, bf16_t* dst, bf16_t* dst_dt, const float* kscale, float* T) {
    const int tid = otid();
    const int ntn = N / 32, tk = tile / ntn, tn = tile % ntn, k0 = tk * 64, n0 = tn * 32;
    __syncthreads();
#pragma unroll
    for (int i = 0; i < 4; ++i) { const int kk = (tid >> 5) + 16 * i, nn = tid & 31; float v = src[(size_t)(k0 + kk) * N + n0 + nn]; if (kscale) v *= kscale[k0 + kk]; T[kk * 33 + nn] = v; }
    __syncthreads();
    const int n = tid >> 4, kp = (tid & 15) * 4;
    int gn = n0 + n; bf16_t* base = dst;
    if (job == 0) { if (gn >= 8224) gn -= 32; else if (gn >= 8192) { gn -= 8192; base = dst_dt; } }
    u32x2 w; w.x = pack2(T[(kp + 0) * 33 + n], T[(kp + 1) * 33 + n]); w.y = pack2(T[(kp + 2) * 33 + n], T[(kp + 3) * 33 + n]);
    *(u32x2*)(base + (size_t)gn * K + k0 + kp) = w;
}

__device__ void phase_prep(CArgs& a, float* ldsf) {
    unsigned char* ws = a.ws; const int tid = otid(); const int bid = obid();
    const int nt0 = 16 * 321, nt1 = 16 * 32, nt2 = 32 * 32, nt3 = 16 * 32, nt4 = 16 * 128, nt5 = 64 * 32;
    const int tot = nt0 + nt1 + nt2 + nt3 + nt4 + nt5;
    for (int t = bid; t < tot; t += gridDim.x) {
        int r = t;
        if (r < nt0) { transpose_tile(a.in[6], 1024, 10272, r, 0, (bf16_t*)(ws + WS_WIN), (bf16_t*)(ws + WS_WDT), nullptr, ldsf); continue; } r -= nt0;
        if (r < nt1) { transpose_tile(a.in[15], 1024, 1024, r, 1, (bf16_t*)(ws + WS_WPA), nullptr, nullptr, ldsf); continue; } r -= nt1;
        if (r < nt2) { transpose_tile(a.in[22], 2048, 1024, r, 2, (bf16_t*)(ws + WS_WPB), nullptr, a.in[21], ldsf); continue; } r -= nt2;
        if (r < nt3) { transpose_tile(a.in[23], 1024, 1024, r, 3, (bf16_t*)(ws + WS_WOUT), nullptr, nullptr, ldsf); continue; } r -= nt3;
        if (r < nt4) { transpose_tile(a.in[26], 1024, 4096, r, 4, (bf16_t*)(ws + WS_WFF1), nullptr, nullptr, ldsf); continue; } r -= nt4;
        transpose_tile(a.in[27], 4096, 1024, r, 5, (bf16_t*)(ws + WS_WFF2), nullptr, nullptr, ldsf);
    }
    for (int idx = bid * NTHREADS + tid; idx < 2 * 65536; idx += gridDim.x * NTHREADS) {
        const int which = idx >> 16, e = idx & 65535, h = e >> 12, j = (e >> 6) & 63, i = e & 63;
        const float* src = which ? a.in[12] : a.in[10]; bf16_t* dst = (bf16_t*)(ws + (which ? WS_WXT : WS_WAT));
        dst[e] = f2bf(src[h * 4096 + i * 64 + j]);
    }
    __syncthreads();
    if (bid < 192) {
        const int jb = bid % 12, ks = bid / 12;
        float* cs = ldsf;
        for (int i = tid; i < 1024; i += NTHREADS) { const int b = i >> 6, k = i & 63; cs[i] = siluf_(a.in[1][b * 1024 + ks * 64 + k]); }
        __syncthreads();
        const int j = jb * 512 + tid;
        float acc[16];
#pragma unroll
        for (int b = 0; b < 16; ++b) acc[b] = 0.f;
        for (int k = 0; k < 64; ++k) { const float w = a.in[2][(size_t)(ks * 64 + k) * NMOD + j];
#pragma unroll
            for (int b = 0; b < 16; ++b) acc[b] += cs[b * 64 + k] * w; }
        float* mp = (float*)(ws + WS_MODP);
#pragma unroll
        for (int b = 0; b < 16; ++b) mp[((size_t)ks * 16 + b) * NMOD + j] = acc[b];
    }
}
__device__ void phase_mod_reduce(CArgs& a) {
    const float* mp = (const float*)(a.ws + WS_MODP); float* mod = (float*)(a.ws + WS_MOD);
    for (int idx = obid() * NTHREADS + otid(); idx < 16 * NMOD; idx += gridDim.x * NTHREADS) {
        const int j = idx % NMOD; float s = a.in[3][j];
        for (int ks = 0; ks < 16; ++ks) s += mp[(size_t)ks * 16 * NMOD + idx];
        mod[idx] = s;
    }
}

__device__ void phase_h1(CArgs& a, int g) {
    const int tid_ = otid(), lane = tid_ & 63, wv = obid() * 8 + (tid_ >> 6), nwv = gridDim.x * 8;
    const float* mod = (const float*)(a.ws + WS_MOD); bf16_t* H = (bf16_t*)(a.ws + WS_H);
    f32x4 nx[4];
    if (wv < TG) { const f32x4* xr = (const f32x4*)(a.in[0] + (size_t)(g * TG + wv) * 1024);
#pragma unroll
        for (int i = 0; i < 4; ++i) nx[i] = xr[lane + 64 * i]; }
    for (int r = wv; r < TG; r += nwv) {
        const int tok = g * TG + r, b = tok / SEQ;
        f32x4 v[4]; float ss = 0.f;
#pragma unroll
        for (int i = 0; i < 4; ++i) { v[i] = nx[i]; ss += v[i][0] * v[i][0] + v[i][1] * v[i][1] + v[i][2] * v[i][2] + v[i][3] * v[i][3]; }
        if (r + nwv < TG) { const f32x4* xr = (const f32x4*)(a.in[0] + (size_t)(tok + nwv) * 1024);
#pragma unroll
            for (int i = 0; i < 4; ++i) nx[i] = xr[lane + 64 * i]; }
        ss = wave_sum(ss, lane); const float rs = rsqrtf(ss * (1.0f / 1024.0f) + EPS);
#pragma unroll
        for (int i = 0; i < 4; ++i) { const int c = (lane + 64 * i) * 4;
            const f32x4 pw = *(const f32x4*)(a.in[4] + c), sh = *(const f32x4*)(mod + b * NMOD + c), sc = *(const f32x4*)(mod + b * NMOD + 1024 + c);
            f32x4 h;
#pragma unroll
            for (int j = 0; j < 4; ++j) h[j] = v[i][j] * rs * pw[j] * (1.0f + sc[j]) + sh[j];
            u32x2 w; w.x = pack2(h[0], h[1]); w.y = pack2(h[2], h[3]); *(u32x2*)(H + (size_t)r * 1024 + c) = w; }
    }
}

__device__ void phase_dt(CArgs& a) {
    const int tid_ = otid(), lane = tid_ & 63, wv = obid() * 8 + (tid_ >> 6), nwv = gridDim.x * 8, fr = lane & 15, fq = lane >> 4;
    const bf16_t* H = (const bf16_t*)(a.ws + WS_H); const bf16_t* W = (const bf16_t*)(a.ws + WS_WDT); float* DT = (float*)(a.ws + WS_DT);
    for (int tile = wv; tile < TG / 16; tile += nwv) {
        f32x4 c0 = {0.f, 0.f, 0.f, 0.f}, c1 = {0.f, 0.f, 0.f, 0.f};
        const bf16_t* ap = H + (size_t)(tile * 16 + fr) * 1024 + fq * 8; const bf16_t* bp0 = W + (size_t)fr * 1024 + fq * 8; const bf16_t* bp1 = W + (size_t)(16 + fr) * 1024 + fq * 8;
#pragma unroll 8
        for (int ks = 0; ks < 32; ++ks) {
            const bf16x8 av = *(const bf16x8*)(ap + ks * 32), b0 = *(const bf16x8*)(bp0 + ks * 32), b1 = *(const bf16x8*)(bp1 + ks * 32);
            c0 = __builtin_amdgcn_mfma_f32_16x16x32_bf16(av, b0, c0, 0, 0, 0);
            c1 = __builtin_amdgcn_mfma_f32_16x16x32_bf16(av, b1, c1, 0, 0, 0);
        }
        const float bi0 = a.in[18][fr], bi1 = a.in[18][16 + fr];
#pragma unroll
        for (int r = 0; r < 4; ++r) { const int t = tile * 16 + fq * 4 + r; DT[(size_t)t * 32 + fr] = softplusf_(c0[r] + bi0); DT[(size_t)t * 32 + 16 + fr] = softplusf_(c1[r] + bi1); }
    }
}

#define TR_ISSUE(dst, addr) asm volatile("ds_read_b64_tr_b16 %0, %1" : "=&v"(dst) : "v"(addr) : "memory")
__device__ __forceinline__ bf16x8 frag_of(u32x2 lo, u32x2 hi) { u32x4 w; w.x = lo.x; w.y = lo.y; w.z = hi.x; w.w = hi.y; return __builtin_bit_cast(bf16x8, w); }
__device__ __forceinline__ void unpack8(u32x4 w, float* f) { f[0] = bflo(w.x); f[1] = bfhi(w.x); f[2] = bflo(w.y); f[3] = bfhi(w.y); f[4] = bflo(w.z); f[5] = bfhi(w.z); f[6] = bflo(w.w); f[7] = bfhi(w.w); }

__device__ void phase_bcconv(CArgs& a, int g) {
    const int gt = obid() * NTHREADS + otid(), nth = gridDim.x * NTHREADS;
    const bf16_t* XBC = (const bf16_t*)(a.ws + WS_XBC); bf16_t* BCc = (bf16_t*)(a.out + (size_t)g * TG * 1024);
    const float* cw = a.in[16]; const float* cb = a.in[17];
    {
        const int cv = gt & 255, c0 = 2048 + cv * 8;
        float w0[8], w1[8], w2[8], w3[8], bs[8];
#pragma unroll
        for (int j = 0; j < 8; ++j) { w0[j] = cw[c0 + j]; w1[j] = cw[4096 + c0 + j]; w2[j] = cw[8192 + c0 + j]; w3[j] = cw[12288 + c0 + j]; bs[j] = cb[c0 + j]; }
        for (int run = gt >> 8; run < TG / 64; run += nth >> 8) {
            const size_t ts = (size_t)run * 64; const bool first = ((run & 63) == 0);
            float x0[8], x1[8], x2[8], x3[8];
#pragma unroll
            for (int j = 0; j < 8; ++j) { x0[j] = 0.f; x1[j] = 0.f; x2[j] = 0.f; }
            if (!first) { unpack8(*(const u32x4*)(XBC + (ts - 3) * 4096 + c0), x0); unpack8(*(const u32x4*)(XBC + (ts - 2) * 4096 + c0), x1); unpack8(*(const u32x4*)(XBC + (ts - 1) * 4096 + c0), x2); }
            for (int i0 = 0; i0 < 64; i0 += 8) {
                u32x4 raw[8];
#pragma unroll
                for (int i = 0; i < 8; ++i) raw[i] = *(const u32x4*)(XBC + (ts + i0 + i) * 4096 + c0);
#pragma unroll
                for (int i = 0; i < 8; ++i) {
                    unpack8(raw[i], x3);
                    float o[8];
#pragma unroll
                    for (int j = 0; j < 8; ++j) { o[j] = siluf_(bs[j] + w0[j] * x0[j] + w1[j] * x1[j] + w2[j] * x2[j] + w3[j] * x3[j]); x0[j] = x1[j]; x1[j] = x2[j]; x2[j] = x3[j]; }
                    u32x4 w; w.x = pack2(o[0], o[1]); w.y = pack2(o[2], o[3]); w.z = pack2(o[4], o[5]); w.w = pack2(o[6], o[7]);
                    *(u32x4*)(BCc + (ts + i0 + i) * 2048 + cv * 8) = w;
                }
            }
        }
    }
    {
        const float* DT = (const float*)(a.ws + WS_DT); float* CS = (float*)(a.ws + WS_CS);
        for (int idx = gt; idx < BG * 64 * 32; idx += nth) {
            const int hh = idx & 31; const size_t t0 = (size_t)(idx >> 5) * 64; const float Ah = -expf(a.in[19][hh]); float run = 0.f;
            for (int i0 = 0; i0 < 64; i0 += 16) { float d[16];
#pragma unroll
                for (int i = 0; i < 16; ++i) d[i] = DT[(t0 + i0 + i) * 32 + hh];
#pragma unroll
                for (int i = 0; i < 16; ++i) { run += d[i] * Ah; CS[(t0 + i0 + i) * 32 + hh] = run; } }
        }
    }
}

__device__ void phase_ssd(CArgs& a, int g, unsigned char* lds) {
    const int tid0 = otid();
    constexpr int OFF_C = 0, OFF_B = 17408, OFF_S = 34816, OFF_X = 52224, OFF_XW = 61440, OFF_G = 70656, OFF_Y = 79872, OFF_CS = 97280, OFF_DT = 97536;
    const unsigned lb = (unsigned)(size_t)lds;
    float* Ys = (float*)(lds + OFF_Y); float* css = (float*)(lds + OFF_CS); float* dts = (float*)(lds + OFF_DT);
    const bf16_t* XBC = (const bf16_t*)(a.ws + WS_XBC); const bf16_t* Z = (const bf16_t*)(a.ws + WS_Z); bf16_t* YB = (bf16_t*)(a.ws + WS_YB);
    const bf16_t* BCc = (const bf16_t*)(a.out + (size_t)g * TG * 1024);
    const float* DT = (const float*)(a.ws + WS_DT); const float* CS = (const float*)(a.ws + WS_CS); const float* cw = a.in[16]; const float* cb = a.in[17];
    for (int unit0 = obid(); unit0 < BG * 32; unit0 += gridDim.x) {
        const int unit = (gridDim.x == 256) ? ((unit0 & 7) * 32 + (unit0 >> 3)) : unit0;
        const int bl = unit >> 5, h = unit & 31, grp = h >> 2;
        const float Dh = a.in[20][h];
        const int sc0w = h * 64 + (tid0 & 7) * 8;
        float w0[8], w1[8], w2[8], w3[8], bs[8];
#pragma unroll
        for (int j = 0; j < 8; ++j) { const int sc0 = sc0w; w0[j] = cw[sc0 + j]; w1[j] = cw[4096 + sc0 + j]; w2[j] = cw[8192 + sc0 + j]; w3[j] = cw[12288 + sc0 + j]; bs[j] = cb[sc0 + j]; }
        f32x4 accs[4];
#pragma unroll
        for (int i = 0; i < 4; ++i) accs[i] = (f32x4){0.f, 0.f, 0.f, 0.f};
        __syncthreads();
        for (int i = tid0; i < 1088; i += NTHREADS) *(u32x4*)(lds + OFF_S + i * 16) = (u32x4){0u, 0u, 0u, 0u};
        u32x4 px[4], pbc[4], pz; float pdt, pcs, pce;
#define SSD_PREFETCH(B_) do { const int b_ = (B_); const int tidp = otid(), ptok = tidp >> 3, pcv = tidp & 7; const size_t tp0 = (size_t)bl * SEQ + b_ * 64; \
        _Pragma("unroll") for (int k = 0; k < 4; ++k) { const int sp = b_ * 64 + ptok - 3 + k; \
            px[k] = (sp >= 0) ? *(const u32x4*)(XBC + ((size_t)bl * SEQ + sp) * 4096 + h * 64 + pcv * 8) : (u32x4){0u, 0u, 0u, 0u}; } \
        pdt = DT[(tp0 + ptok) * 32 + h]; pcs = CS[(tp0 + ptok) * 32 + h]; pce = CS[(tp0 + 63) * 32 + h]; \
        pz = *(const u32x4*)(Z + (tp0 + ptok) * 2048 + h * 64 + pcv * 8); \
        _Pragma("unroll") for (int i = 0; i < 4; ++i) { const int idx = tidp + 512 * i, which = idx >> 10, rem = idx & 1023, row = rem >> 4, ch = rem & 15; \
            pbc[i] = *(const u32x4*)(BCc + (tp0 + row) * 2048 + which * 1024 + grp * 128 + ch * 8); } } while (0)
        SSD_PREFETCH(0);
        for (int blk = 0; blk < SEQ / 64; ++blk) {
            const size_t t0 = (size_t)bl * SEQ + blk * 64;
            const int tid = otid(), lane = tid & 63, wid = __builtin_amdgcn_readfirstlane(tid >> 6), fr = lane & 15, fq = lane >> 4, tq = (lane & 15) >> 2, tp = lane & 3;
            const int stok = tid >> 3, scv = tid & 7;
            const u32x4 zcur = pz;
            {
                float xr[4][8];
#pragma unroll
                for (int k = 0; k < 4; ++k) unpack8(px[k], xr[k]);
                const float dtv = pdt, csv = pcs, cse = pce, wgt = dtv * __expf(cse - csv);
                float o[8];
#pragma unroll
                for (int j = 0; j < 8; ++j) o[j] = siluf_(bs[j] + w0[j] * xr[0][j] + w1[j] * xr[1][j] + w2[j] * xr[2][j] + w3[j] * xr[3][j]);
                u32x4 w; w.x = pack2(o[0], o[1]); w.y = pack2(o[2], o[3]); w.z = pack2(o[4], o[5]); w.w = pack2(o[6], o[7]);
                *(u32x4*)(lds + OFF_X + stok * 144 + scv * 16) = w;
                w.x = pack2(o[0] * wgt, o[1] * wgt); w.y = pack2(o[2] * wgt, o[3] * wgt); w.z = pack2(o[4] * wgt, o[5] * wgt); w.w = pack2(o[6] * wgt, o[7] * wgt);
                *(u32x4*)(lds + OFF_XW + stok * 144 + scv * 16) = w;
                if (scv == 0) { css[stok] = csv; dts[stok] = dtv; }
#pragma unroll
                for (int i = 0; i < 4; ++i) { const int idx = tid + 512 * i, which = idx >> 10, rem = idx & 1023, row = rem >> 4, ch = rem & 15;
                    *(u32x4*)(lds + (which ? OFF_C : OFF_B) + row * 272 + ch * 16) = pbc[i]; }
            }
            if (blk + 1 < SEQ / 64) SSD_PREFETCH(blk + 1);
            __syncthreads();
            const int li = wid >> 1, si0 = (wid * 2) & 3, si1 = si0 + 1;
            bf16x8 cfr[4], avA[4], avB[4];
#pragma unroll
            for (int ks = 0; ks < 4; ++ks) { cfr[ks] = *(const bf16x8*)(lds + OFF_C + (li * 16 + fr) * 272 + ks * 64 + fq * 16);
                avA[ks] = *(const bf16x8*)(lds + OFF_B + (si0 * 16 + fr) * 272 + ks * 64 + fq * 16); avB[ks] = *(const bf16x8*)(lds + OFF_B + (si1 * 16 + fr) * 272 + ks * 64 + fq * 16); }
            const float csl = css[li * 16 + fr];
            const f32x4 csA = *(const f32x4*)(css + si0 * 16 + fq * 4), dtA = *(const f32x4*)(dts + si0 * 16 + fq * 4), csB = *(const f32x4*)(css + si1 * 16 + fq * 4), dtB = *(const f32x4*)(dts + si1 * 16 + fq * 4);
            {
                u32x2 gwA = {0u, 0u}, gwB = {0u, 0u}; const int l = li * 16 + fr;
                if (si0 <= li) { f32x4 acc = {0.f, 0.f, 0.f, 0.f};
#pragma unroll
                    for (int ks = 0; ks < 4; ++ks) acc = __builtin_amdgcn_mfma_f32_16x16x32_bf16(avA[ks], cfr[ks], acc, 0, 0, 0);
                    float gv[4];
#pragma unroll
                    for (int r = 0; r < 4; ++r) { const int sidx = si0 * 16 + fq * 4 + r; gv[r] = (sidx <= l) ? acc[r] * __expf(csl - csA[r]) * dtA[r] : 0.f; }
                    gwA.x = pack2(gv[0], gv[1]); gwA.y = pack2(gv[2], gv[3]); }
                if (si1 <= li) { f32x4 acc = {0.f, 0.f, 0.f, 0.f};
#pragma unroll
                    for (int ks = 0; ks < 4; ++ks) acc = __builtin_amdgcn_mfma_f32_16x16x32_bf16(avB[ks], cfr[ks], acc, 0, 0, 0);
                    float gv[4];
#pragma unroll
                    for (int r = 0; r < 4; ++r) { const int sidx = si1 * 16 + fq * 4 + r; gv[r] = (sidx <= l) ? acc[r] * __expf(csl - csB[r]) * dtB[r] : 0.f; }
                    gwB.x = pack2(gv[0], gv[1]); gwB.y = pack2(gv[2], gv[3]); }
                *(u32x2*)(lds + OFF_G + (li * 16 + fr) * 144 + (si0 * 16 + fq * 4) * 2) = gwA;
                *(u32x2*)(lds + OFF_G + (li * 16 + fr) * 144 + (si1 * 16 + fq * 4) * 2) = gwB;
            }
            __syncthreads();
            {
                const int pi0 = (wid * 2) & 3;
                const bf16x8 g0 = *(const bf16x8*)(lds + OFF_G + (li * 16 + fr) * 144 + fq * 16), g1 = *(const bf16x8*)(lds + OFF_G + (li * 16 + fr) * 144 + 64 + fq * 16);
                const f32x4 csl4 = *(const f32x4*)(css + li * 16 + fq * 4); const float cs63 = css[63];
                bf16x8 svA[4], svB[4];
#pragma unroll
                for (int ks = 0; ks < 4; ++ks) { svA[ks] = *(const bf16x8*)(lds + OFF_S + (pi0 * 16 + fr) * 272 + ks * 64 + fq * 16); svB[ks] = *(const bf16x8*)(lds + OFF_S + ((pi0 + 1) * 16 + fr) * 272 + ks * 64 + fq * 16); }
                bf16_t xsA[4], xsB[4];
#pragma unroll
                for (int r = 0; r < 4; ++r) { xsA[r] = *(const bf16_t*)(lds + OFF_X + (li * 16 + fq * 4 + r) * 144 + (pi0 * 16 + fr) * 2); xsB[r] = *(const bf16_t*)(lds + OFF_X + (li * 16 + fq * 4 + r) * 144 + ((pi0 + 1) * 16 + fr) * 2); }
                u32x2 xa0, xa1, xa2, xa3, xb0, xb1, xb2, xb3;
                {   const unsigned xa = lb + OFF_X + (8 * fq + tq) * 144 + (pi0 * 16 + 4 * tp) * 2, xb = xa + 32;
                    TR_ISSUE(xa0, xa); TR_ISSUE(xa1, xa + 4 * 144); TR_ISSUE(xa2, xa + 32 * 144); TR_ISSUE(xa3, xa + 36 * 144);
                    TR_ISSUE(xb0, xb); TR_ISSUE(xb1, xb + 4 * 144); TR_ISSUE(xb2, xb + 32 * 144); TR_ISSUE(xb3, xb + 36 * 144); }
                asm volatile("s_waitcnt lgkmcnt(0)" : "+v"(xa0), "+v"(xa1), "+v"(xa2), "+v"(xa3), "+v"(xb0), "+v"(xb1), "+v"(xb2), "+v"(xb3) :: "memory");
                f32x4 adA = {0.f, 0.f, 0.f, 0.f}, aoA = {0.f, 0.f, 0.f, 0.f}, adB = {0.f, 0.f, 0.f, 0.f}, aoB = {0.f, 0.f, 0.f, 0.f};
                adA = __builtin_amdgcn_mfma_f32_16x16x32_bf16(g0, frag_of(xa0, xa1), adA, 0, 0, 0); adB = __builtin_amdgcn_mfma_f32_16x16x32_bf16(g0, frag_of(xb0, xb1), adB, 0, 0, 0);
                if (li >= 2) { adA = __builtin_amdgcn_mfma_f32_16x16x32_bf16(g1, frag_of(xa2, xa3), adA, 0, 0, 0); adB = __builtin_amdgcn_mfma_f32_16x16x32_bf16(g1, frag_of(xb2, xb3), adB, 0, 0, 0); }
#pragma unroll
                for (int ks = 0; ks < 4; ++ks) { aoA = __builtin_amdgcn_mfma_f32_16x16x32_bf16(cfr[ks], svA[ks], aoA, 0, 0, 0); aoB = __builtin_amdgcn_mfma_f32_16x16x32_bf16(cfr[ks], svB[ks], aoB, 0, 0, 0); }
                u32x2 b0, b1, b2, b3, q0, q1, q2, q3, q4, q5, q6, q7, r0, r1, r2, r3, r4, r5, r6, r7;
                {   const unsigned ba = lb + OFF_B + (8 * fq + tq) * 272 + (wid * 16 + 4 * tp) * 2, qa = lb + OFF_XW + (8 * fq + tq) * 144 + (4 * tp) * 2, qb = qa + 32 * 144;
                    TR_ISSUE(b0, ba); TR_ISSUE(b1, ba + 4 * 272); TR_ISSUE(b2, ba + 32 * 272); TR_ISSUE(b3, ba + 36 * 272);
                    TR_ISSUE(q0, qa); TR_ISSUE(q1, qa + 4 * 144); TR_ISSUE(q2, qa + 32); TR_ISSUE(q3, qa + 32 + 4 * 144);
                    TR_ISSUE(q4, qa + 64); TR_ISSUE(q5, qa + 64 + 4 * 144); TR_ISSUE(q6, qa + 96); TR_ISSUE(q7, qa + 96 + 4 * 144);
                    TR_ISSUE(r0, qb); TR_ISSUE(r1, qb + 4 * 144); TR_ISSUE(r2, qb + 32); TR_ISSUE(r3, qb + 32 + 4 * 144);
                    TR_ISSUE(r4, qb + 64); TR_ISSUE(r5, qb + 64 + 4 * 144); TR_ISSUE(r6, qb + 96); TR_ISSUE(r7, qb + 96 + 4 * 144); }
                float yA[4], yB[4];
#pragma unroll
                for (int r = 0; r < 4; ++r) { const float e = __expf(csl4[r]); yA[r] = adA[r] + e * aoA[r] + Dh * bf2f(xsA[r]); yB[r] = adB[r] + e * aoB[r] + Dh * bf2f(xsB[r]); }
                asm volatile("s_waitcnt lgkmcnt(0)" : "+v"(b0), "+v"(b1), "+v"(b2), "+v"(b3), "+v"(q0), "+v"(q1), "+v"(q2), "+v"(q3), "+v"(q4), "+v"(q5), "+v"(q6), "+v"(q7) :: "memory");
                asm volatile("" : "+v"(r0), "+v"(r1), "+v"(r2), "+v"(r3), "+v"(r4), "+v"(r5), "+v"(r6), "+v"(r7) :: "memory");
                const float dec = __expf(cs63);
#pragma unroll
                for (int pt = 0; pt < 4; ++pt) accs[pt] *= dec;
                {   const bf16x8 bf0 = frag_of(b0, b1), bf1 = frag_of(b2, b3);
                    accs[0] = __builtin_amdgcn_mfma_f32_16x16x32_bf16(bf0, frag_of(q0, q1), accs[0], 0, 0, 0);
                    accs[1] = __builtin_amdgcn_mfma_f32_16x16x32_bf16(bf0, frag_of(q2, q3), accs[1], 0, 0, 0);
                    accs[2] = __builtin_amdgcn_mfma_f32_16x16x32_bf16(bf0, frag_of(q4, q5), accs[2], 0, 0, 0);
                    accs[3] = __builtin_amdgcn_mfma_f32_16x16x32_bf16(bf0, frag_of(q6, q7), accs[3], 0, 0, 0);
                    accs[0] = __builtin_amdgcn_mfma_f32_16x16x32_bf16(bf1, frag_of(r0, r1), accs[0], 0, 0, 0);
                    accs[1] = __builtin_amdgcn_mfma_f32_16x16x32_bf16(bf1, frag_of(r2, r3), accs[1], 0, 0, 0);
                    accs[2] = __builtin_amdgcn_mfma_f32_16x16x32_bf16(bf1, frag_of(r4, r5), accs[2], 0, 0, 0);
                    accs[3] = __builtin_amdgcn_mfma_f32_16x16x32_bf16(bf1, frag_of(r6, r7), accs[3], 0, 0, 0); }
#pragma unroll
                for (int r = 0; r < 4; ++r) { const int l = li * 16 + fq * 4 + r; Ys[l * 68 + pi0 * 16 + fr] = yA[r]; Ys[l * 68 + (pi0 + 1) * 16 + fr] = yB[r]; }
            }
            __syncthreads();
#pragma unroll
            for (int pt = 0; pt < 4; ++pt) { u32x2 w; w.x = pack2(accs[pt][0], accs[pt][1]); w.y = pack2(accs[pt][2], accs[pt][3]);
                *(u32x2*)(lds + OFF_S + (pt * 16 + fr) * 272 + (wid * 16 + fq * 4) * 2) = w; }
            {   const f32x4 y0 = *(const f32x4*)(Ys + stok * 68 + scv * 8), y1 = *(const f32x4*)(Ys + stok * 68 + scv * 8 + 4);
                u32x4 w; w.x = pack2(y0[0] * bflo(zcur.x), y0[1] * bfhi(zcur.x)); w.y = pack2(y0[2] * bflo(zcur.y), y0[3] * bfhi(zcur.y));
                w.z = pack2(y1[0] * bflo(zcur.z), y1[1] * bfhi(zcur.z)); w.w = pack2(y1[2] * bflo(zcur.w), y1[3] * bfhi(zcur.w));
                *(u32x4*)(YB + (t0 + stok) * 2048 + h * 64 + scv * 8) = w; }
        }
#undef SSD_PREFETCH
    }
}

__device__ void phase_lru(CArgs& a, unsigned char* lds) {
    const int tid = otid(), lane = tid & 63, wid = __builtin_amdgcn_readfirstlane(tid >> 6), fr = lane & 15, fq = lane >> 4;
    bf16_t* XCb = (bf16_t*)lds;
    float* XCf = (float*)(lds + 9216);
    float* SP = XCf + 64 * 68; float* SH = SP + 512;
    const bf16_t* LX = (const bf16_t*)(a.ws + WS_LX); const bf16_t* LG = (const bf16_t*)(a.ws + WS_LG); bf16_t* YA = (bf16_t*)(a.ws + WS_H);
    const bf16_t* WAT = (const bf16_t*)(a.ws + WS_WAT); const bf16_t* WXT = (const bf16_t*)(a.ws + WS_WXT);
    const float* cw = a.in[8]; const float* cb = a.in[9];
    for (int unit = obid(); unit < BG * 32; unit += gridDim.x) {
        const int bl = unit >> 5, h = (unit >> 1) & 15, jh = unit & 1;
        const int stok = tid >> 3, scv = tid & 7, sc0 = h * 64 + scv * 8;
        float w0[8], w1[8], w2[8], w3[8], bs[8];
#pragma unroll
        for (int j = 0; j < 8; ++j) { w0[j] = cw[sc0 + j]; w1[j] = cw[1024 + sc0 + j]; w2[j] = cw[2048 + sc0 + j]; w3[j] = cw[3072 + sc0 + j]; bs[j] = cb[sc0 + j]; }
        const int tt = wid & 3, nt = wid >> 2, jj = nt * 16 + fr, chg = h * 64 + jh * 32 + jj, seg = tt * 4 + fq;
        const size_t wo = (size_t)h * 4096 + (size_t)(jh * 32 + jj) * 64 + fq * 8;
        const bf16x8 wa0 = *(const bf16x8*)(WAT + wo), wa1 = *(const bf16x8*)(WAT + wo + 32), wx0 = *(const bf16x8*)(WXT + wo), wx1 = *(const bf16x8*)(WXT + wo + 32);
        const float bav = a.in[11][chg], bxv = a.in[13][chg], spv = softplusf_(-a.in[14][chg]);
        float hc = 0.f;
        u32x4 px[4];
#define LRU_PREFETCH(B_) do { const int b_ = (B_); _Pragma("unroll") for (int k = 0; k < 4; ++k) { const int sp = b_ * 64 + stok - 3 + k; \
        px[k] = (sp >= 0) ? *(const u32x4*)(LX + ((size_t)bl * SEQ + sp) * 1024 + sc0) : (u32x4){0u, 0u, 0u, 0u}; } } while (0)
        LRU_PREFETCH(0);
        __syncthreads();
        for (int blk = 0; blk < SEQ / 64; ++blk) {
            const size_t t0 = (size_t)bl * SEQ + blk * 64;
            {
                float xr[4][8];
#pragma unroll
                for (int k = 0; k < 4; ++k) unpack8(px[k], xr[k]);
                float o[8];
#pragma unroll
                for (int j = 0; j < 8; ++j) o[j] = bs[j] + w0[j] * xr[0][j] + w1[j] * xr[1][j] + w2[j] * xr[2][j] + w3[j] * xr[3][j];
                u32x4 w; w.x = pack2(o[0], o[1]); w.y = pack2(o[2], o[3]); w.z = pack2(o[4], o[5]); w.w = pack2(o[6], o[7]);
                *(u32x4*)(XCb + stok * 72 + scv * 8) = w;
                *(f32x4*)(XCf + stok * 68 + scv * 8) = (f32x4){o[0], o[1], o[2], o[3]}; *(f32x4*)(XCf + stok * 68 + scv * 8 + 4) = (f32x4){o[4], o[5], o[6], o[7]};
            }
            bf16_t lgv[4];
#pragma unroll
            for (int r = 0; r < 4; ++r) lgv[r] = LG[(t0 + tt * 16 + fq * 4 + r) * 1024 + chg];
            if (blk + 1 < SEQ / 64) LRU_PREFETCH(blk + 1);
            __syncthreads();
            f32x4 cr = {0.f, 0.f, 0.f, 0.f}, ci = {0.f, 0.f, 0.f, 0.f};
            {   const bf16x8 a0 = *(const bf16x8*)(XCb + (tt * 16 + fr) * 72 + fq * 8), a1 = *(const bf16x8*)(XCb + (tt * 16 + fr) * 72 + 32 + fq * 8);
                cr = __builtin_amdgcn_mfma_f32_16x16x32_bf16(a0, wa0, cr, 0, 0, 0); cr = __builtin_amdgcn_mfma_f32_16x16x32_bf16(a1, wa1, cr, 0, 0, 0);
                ci = __builtin_amdgcn_mfma_f32_16x16x32_bf16(a0, wx0, ci, 0, 0, 0); ci = __builtin_amdgcn_mfma_f32_16x16x32_bf16(a1, wx1, ci, 0, 0, 0); }
            float hl[4], cp[4];
#pragma unroll
            for (int r = 0; r < 4; ++r) { const int tok = tt * 16 + fq * 4 + r;
                const float rr = sigmoidf_(cr[r] + bav), ii = sigmoidf_(ci[r] + bxv);
                const float la = -8.0f * rr * spv, av = __expf(la), uv = __builtin_amdgcn_sqrtf(fmaxf(1.0f - av * av, 0.f)) * ii * XCf[tok * 68 + jh * 32 + jj];
                if (r == 0) { hl[0] = uv; cp[0] = av; } else { hl[r] = av * hl[r - 1] + uv; cp[r] = cp[r - 1] * av; } }
            SP[seg * 32 + jj] = cp[3]; SH[seg * 32 + jj] = hl[3];
            __syncthreads();
            float c = hc, mine = 0.f;
#pragma unroll
            for (int s2 = 0; s2 < 16; ++s2) { if (s2 == seg) mine = c; c = SP[s2 * 32 + jj] * c + SH[s2 * 32 + jj]; }
            hc = c;
#pragma unroll
            for (int r = 0; r < 4; ++r) { const float hv = hl[r] + cp[r] * mine; YA[(t0 + tt * 16 + fq * 4 + r) * 1024 + chg] = f2bf(hv * geluf_(bf2f(lgv[r]))); }
        }
    }
}


__device__ void phase_gnorm(CArgs& a) {
    const int tid_ = otid(), lane = tid_ & 63, wv = obid() * 8 + (tid_ >> 6), nwv = gridDim.x * 8;
    bf16_t* YB = (bf16_t*)(a.ws + WS_YB);
    for (int item = wv; item < TG * 8; item += 16 * nwv) {
        u32x2 w[16];
#pragma unroll
        for (int k = 0; k < 16; ++k) w[k] = (item + k * nwv < TG * 8) ? *(const u32x2*)(YB + (size_t)(item + k * nwv) * 256 + lane * 4) : (u32x2){0u, 0u};
#pragma unroll
        for (int k = 0; k < 16; ++k) {
            const float f0 = bflo(w[k].x), f1 = bfhi(w[k].x), f2 = bflo(w[k].y), f3 = bfhi(w[k].y);
            const float ss = wave_sum(f0 * f0 + f1 * f1 + f2 * f2 + f3 * f3, lane), rs = rsqrtf(ss * (1.0f / 256.0f) + EPS);
            u32x2 o; o.x = pack2(f0 * rs, f1 * rs); o.y = pack2(f2 * rs, f3 * rs); if (item + k * nwv < TG * 8) *(u32x2*)(YB + (size_t)(item + k * nwv) * 256 + lane * 4) = o; }
    }
}

__device__ void phase_mid(CArgs& a, int g) {
    const int tid_ = otid(), lane = tid_ & 63, wv = obid() * 8 + (tid_ >> 6), nwv = gridDim.x * 8;
    const float* mod = (const float*)(a.ws + WS_MOD); bf16_t* H = (bf16_t*)(a.ws + WS_H); const bf16_t* Y1 = (const bf16_t*)(a.ws + WS_XBC + (size_t)TG * 1024 * 4);
    bf16_t* X2 = (bf16_t*)(a.ws + WS_LG);
    u32x2 ny[4]; f32x4 nx[4];
    if (wv < TG) { const u32x2* yr = (const u32x2*)(Y1 + (size_t)wv * 1024); const f32x4* xr = (const f32x4*)(a.in[0] + (size_t)(g * TG + wv) * 1024);
#pragma unroll
        for (int i = 0; i < 4; ++i) { ny[i] = yr[lane + 64 * i]; nx[i] = xr[lane + 64 * i]; } }
    for (int r = wv; r < TG; r += nwv) {
        const int tok = g * TG + r, b = tok / SEQ;
        f32x4 y[4], xv[4]; float ss = 0.f;
#pragma unroll
        for (int i = 0; i < 4; ++i) { const u32x2 yw = ny[i]; xv[i] = nx[i]; y[i] = (f32x4){bflo(yw.x), bfhi(yw.x), bflo(yw.y), bfhi(yw.y)}; ss += y[i][0] * y[i][0] + y[i][1] * y[i][1] + y[i][2] * y[i][2] + y[i][3] * y[i][3]; }
        if (r + nwv < TG) { const u32x2* yr = (const u32x2*)(Y1 + (size_t)(r + nwv) * 1024); const f32x4* xr = (const f32x4*)(a.in[0] + (size_t)(tok + nwv) * 1024);
#pragma unroll
            for (int i = 0; i < 4; ++i) { ny[i] = yr[lane + 64 * i]; nx[i] = xr[lane + 64 * i]; } }
        ss = wave_sum(ss, lane); const float rs = rsqrtf(ss * (1.0f / 1024.0f) + EPS);
        float ss2 = 0.f;
#pragma unroll
        for (int i = 0; i < 4; ++i) { const int c = (lane + 64 * i) * 4; const f32x4 pw = *(const f32x4*)(a.in[5] + c), g1 = *(const f32x4*)(mod + b * NMOD + 2048 + c);
#pragma unroll
            for (int j = 0; j < 4; ++j) { y[i][j] = xv[i][j] + g1[j] * (y[i][j] * rs * pw[j]); ss2 += y[i][j] * y[i][j]; }
            { u32x2 w; w.x = pack2(y[i][0], y[i][1]); w.y = pack2(y[i][2], y[i][3]); *(u32x2*)(X2 + (size_t)r * 1024 + c) = w; } }
        ss2 = wave_sum(ss2, lane); const float rs2 = rsqrtf(ss2 * (1.0f / 1024.0f) + EPS);
#pragma unroll
        for (int i = 0; i < 4; ++i) { const int c = (lane + 64 * i) * 4;
            const f32x4 pw = *(const f32x4*)(a.in[24] + c), sh = *(const f32x4*)(mod + b * NMOD + 3072 + c), sc = *(const f32x4*)(mod + b * NMOD + 4096 + c);
            u32x2 w; w.x = pack2(y[i][0] * rs2 * pw[0] * (1.0f + sc[0]) + sh[0], y[i][1] * rs2 * pw[1] * (1.0f + sc[1]) + sh[1]);
            w.y = pack2(y[i][2] * rs2 * pw[2] * (1.0f + sc[2]) + sh[2], y[i][3] * rs2 * pw[3] * (1.0f + sc[3]) + sh[3]);
            *(u32x2*)(H + (size_t)r * 1024 + c) = w; }
    }
}

__device__ void phase_final(CArgs& a, int g) {
    const int tid_ = otid(), lane = tid_ & 63, wv = obid() * 8 + (tid_ >> 6), nwv = gridDim.x * 8;
    const float* mod = (const float*)(a.ws + WS_MOD); const bf16_t* Y2 = (const bf16_t*)(a.ws + WS_Z); const bf16_t* X2 = (const bf16_t*)(a.ws + WS_LG);
    u32x2 ny[4], nx[4];
    if (wv < TG) { const u32x2* yr = (const u32x2*)(Y2 + (size_t)wv * 1024); const u32x2* xr = (const u32x2*)(X2 + (size_t)wv * 1024);
#pragma unroll
        for (int i = 0; i < 4; ++i) { ny[i] = yr[lane + 64 * i]; nx[i] = xr[lane + 64 * i]; } }
    for (int r = wv; r < TG; r += nwv) {
        const int tok = g * TG + r, b = tok / SEQ;
        f32x4 y[4], xv[4]; float ss = 0.f;
#pragma unroll
        for (int i = 0; i < 4; ++i) { const u32x2 yw = ny[i], xw = nx[i]; xv[i] = (f32x4){bflo(xw.x), bfhi(xw.x), bflo(xw.y), bfhi(xw.y)}; y[i] = (f32x4){bflo(yw.x), bfhi(yw.x), bflo(yw.y), bfhi(yw.y)};
            ss += y[i][0] * y[i][0] + y[i][1] * y[i][1] + y[i][2] * y[i][2] + y[i][3] * y[i][3]; }
        if (r + nwv < TG) { const u32x2* yr = (const u32x2*)(Y2 + (size_t)(r + nwv) * 1024); const u32x2* xr = (const u32x2*)(X2 + (size_t)(r + nwv) * 1024);
#pragma unroll
            for (int i = 0; i < 4; ++i) { ny[i] = yr[lane + 64 * i]; nx[i] = xr[lane + 64 * i]; } }
        ss = wave_sum(ss, lane); const float rs = rsqrtf(ss * (1.0f / 1024.0f) + EPS);
#pragma unroll
        for (int i = 0; i < 4; ++i) { const int c = (lane + 64 * i) * 4; const f32x4 pw = *(const f32x4*)(a.in[25] + c), g2 = *(const f32x4*)(mod + b * NMOD + 5120 + c);
#pragma unroll
            for (int j = 0; j < 4; ++j) xv[i][j] += g2[j] * (y[i][j] * rs * pw[j]);
            *(f32x4*)(a.out + (size_t)tok * 1024 + c) = xv[i]; }
    }
}

__global__ void __launch_bounds__(NTHREADS, 2) fwd_megakernel(Args a_unused) {
    extern __shared__ __attribute__((aligned(16))) unsigned char lds[];
    cg::grid_group grid = cg::this_grid();
    CArgs* ap0 = (CArgs*)__builtin_amdgcn_kernarg_segment_ptr();
#define AA (*launder(ap0))
    const int G = gridDim.x, bid = obid();
    LAS unsigned char* ldsl = (LAS unsigned char*)lds;

    volatile LAS unsigned* xst = (volatile LAS unsigned*)(ldsl + 131072);
    if (threadIdx.x < 4) xst[threadIdx.x] = 0u;
    __syncthreads();
    const XcdBarrier xb = xcd_barrier_post((unsigned*)(AA.ws + WS_BAR), xst);
    phase_prep(AA, (float*)lds);
    {   int never = 0; asm volatile("" : "+s"(never));
        if (never) grid.sync();
        xcd_barrier(xb); }
    phase_mod_reduce(AA);
    xcd_barrier(xb);

    for (int g = 0; g < NB; ++g) {
        phase_h1(AA, g);
        xcd_barrier(xb);
        phase_dt(AA);
        {   pg8::Gemm gm{(const bf16_t*)(AA.ws + WS_H), (const bf16_t*)(AA.ws + WS_WIN), TG, NIN, 1024}; pg8::StaticOrder S; S.init(TG, NIN, G, bid, 1);
            EpiIn E{(bf16_t*)(AA.ws + WS_LX), (bf16_t*)(AA.ws + WS_LG), (bf16_t*)(AA.ws + WS_Z), (bf16_t*)(AA.ws + WS_XBC), (bf16_t*)(AA.ws + WS_GT)};
            pg8::gemm_phase<EpiIn>(ldsl, gm, S, E); }
        xcd_barrier(xb);
        phase_bcconv(AA, g);
        phase_lru(AA, lds);
        xcd_barrier(xb);
        phase_ssd(AA, g, lds);
        xcd_barrier(xb);
        phase_gnorm(AA);
        xcd_barrier(xb);
        {   pg8::StaticOrder S; S.init(TG, 1024, G, bid);
            pg8::Gemm g1{(const bf16_t*)(AA.ws + WS_H), (const bf16_t*)(AA.ws + WS_WPA), TG, 1024, 1024};
            EpiPa E1{(bf16_t*)(AA.ws + WS_XBC), (const bf16_t*)(AA.ws + WS_GT), AA.in[7]};
            pg8::gemm_phase<EpiPa>(ldsl, g1, S, E1);
            pg8::Gemm g2{(const bf16_t*)(AA.ws + WS_YB), (const bf16_t*)(AA.ws + WS_WPB), TG, 1024, 2048};
            EpiPb E2{(const bf16_t*)(AA.ws + WS_XBC), (const bf16_t*)(AA.ws + WS_GT), (bf16_t*)(AA.ws + WS_LX), AA.in[7]};
            pg8::gemm_phase<EpiPb>(ldsl, g2, S, E2); }
        xcd_barrier(xb);
        {   pg8::StaticOrder S; S.init(TG, 1024, G, bid);
            pg8::Gemm g3{(const bf16_t*)(AA.ws + WS_LX), (const bf16_t*)(AA.ws + WS_WOUT), TG, 1024, 1024};
            EpiBf E{(bf16_t*)(AA.ws + WS_XBC + (size_t)TG * 1024 * 4), 1024};
            pg8::gemm_phase<EpiBf>(ldsl, g3, S, E); }
        xcd_barrier(xb);
        phase_mid(AA, g);
        xcd_barrier(xb);
        {   pg8::StaticOrder S; S.init(TG, 4096, G, bid);
            pg8::Gemm g4{(const bf16_t*)(AA.ws + WS_H), (const bf16_t*)(AA.ws + WS_WFF1), TG, 4096, 1024};
            EpiRelu2 E{(bf16_t*)(AA.ws + WS_XBC), 4096};
            pg8::gemm_phase<EpiRelu2>(ldsl, g4, S, E); }
        xcd_barrier(xb);
        {   pg8::StaticOrder S; S.init(TG, 1024, G, bid);
            pg8::Gemm g5{(const bf16_t*)(AA.ws + WS_XBC), (const bf16_t*)(AA.ws + WS_WFF2), TG, 1024, 4096};
            EpiBf E{(bf16_t*)(AA.ws + WS_Z), 1024};
            pg8::gemm_phase<EpiBf>(ldsl, g5, S, E); }
        xcd_barrier(xb);
        phase_final(AA, g);
    }
}

extern "C" void kernel_launch(void* const* d_in, const int* in_sizes, int n_in, void* d_out, int out_size, void* d_ws, size_t ws_size, hipStream_t stream) {
    static int grid_blocks = 0;
    if (!grid_blocks) {
        int dev = 0, cus = 0, per_cu = 0;
        hipGetDevice(&dev);
        hipDeviceGetAttribute(&cus, hipDeviceAttributeMultiprocessorCount, dev);
        hipFuncSetAttribute((const void*)fwd_megakernel, hipFuncAttributeMaxDynamicSharedMemorySize, LDS_BYTES);
        hipOccupancyMaxActiveBlocksPerMultiprocessor(&per_cu, (const void*)fwd_megakernel, NTHREADS, LDS_BYTES);
        if (per_cu < 1) per_cu = 1;
        grid_blocks = cus * per_cu;
        if (ws_size < WS_END) fprintf(stderr, "kernel_launch: workspace too small: %zu < %zu\n", ws_size, (size_t)WS_END);
    }
    Args a{};
    for (int i = 0; i < 28; ++i) a.in[i] = (const float*)d_in[i];
    a.out = (float*)d_out; a.ws = (unsigned char*)d_ws;
    (void)hipMemsetAsync((unsigned char*)d_ws + WS_BAR, 0, 16384, stream);
    void* args[] = {&a};
    hipError_t e = hipLaunchCooperativeKernel((const void*)fwd_megakernel, dim3(grid_blocks), dim3(NTHREADS), args, LDS_BYTES, stream);
    if (e != hipSuccess) fprintf(stderr, "cooperative launch failed: %s (grid %d)\n", hipGetErrorString(e), grid_blocks);
}
```
